# Optimizing an MI355X kernel written in HIP

```python
import math
import jax, jax.numpy as jnp
from jax import lax
import numpy as np

D_MODEL = 1024
BATCH = 4
SEQ = 4096
DEPTH = 2
DEC_BATCH = 32
DEC_SEQ = 64
PAST_LEN = 2048

CHUNK = 64
MIX_WIDTH = D_MODEL
C_CONV = MIX_WIDTH // 2
CONV_W = 31
GLA_HEADS = 4
GLA_DV = (MIX_WIDTH // 2) // GLA_HEADS
GLA_DK = GLA_DV // 2
GATE_RANK = 16
GATE_TAU = 16.0
D_FF = 2816
EPS = 1e-6

QK_W = GLA_HEADS * GLA_DK
V_W = GLA_HEADS * GLA_DV
IN_W = 2 * C_CONV + 2 * QK_W + 2 * V_W + GATE_RANK
SPLITS = (C_CONV, 2 * C_CONV, 2 * C_CONV + QK_W, 2 * C_CONV + 2 * QK_W,
          2 * C_CONV + 2 * QK_W + V_W, 2 * C_CONV + 2 * QK_W + 2 * V_W)

kernel_name = "hymba_conformer_gla_stream_step"


def rmsnorm(x, g):
    xf = x.astype(jnp.float32)
    y = xf * lax.rsqrt(jnp.mean(xf * xf, axis=-1, keepdims=True) + EPS)
    return (y * g.astype(jnp.float32)).astype(x.dtype)


def layernorm(x, g, b):
    xf = x.astype(jnp.float32)
    mu = jnp.mean(xf, axis=-1, keepdims=True)
    xc = xf - mu
    y = xc * lax.rsqrt(jnp.mean(xc * xc, axis=-1, keepdims=True) + EPS)
    return (y * g.astype(jnp.float32) + b.astype(jnp.float32)).astype(x.dtype)


def swiglu(x, wg, wu, wd):
    return (jax.nn.silu(x @ wg) * (x @ wu)) @ wd


def conv_module(u_a, u_b, conv_cache, dw_w, dw_b, ln_g, ln_b):
    z = u_a * jax.nn.sigmoid(u_b)
    zp = jnp.concatenate([conv_cache.astype(z.dtype), z], axis=1)
    y = lax.conv_general_dilated(zp, dw_w[:, None, :].astype(z.dtype), window_strides=(1,),
                                 padding='VALID', dimension_numbers=('NWC', 'WIO', 'NWC'),
                                 feature_group_count=C_CONV) + dw_b
    y = jax.nn.silu(layernorm(y, ln_g, ln_b))
    return y, zp[:, -(CONV_W - 1):]


def gla_chunk_step(S, inp):
    q, k, v, la = inp
    b = jnp.cumsum(la, axis=1)
    o_inter = jnp.einsum('bchk,bhkv->bchv', q * jnp.exp(b), S)
    c = q.shape[1]
    causal = (jnp.arange(c)[:, None] >= jnp.arange(c)[None, :])[None, :, :, None, None]
    diff = b[:, :, None] - b[:, None, :]
    decay = jnp.exp(jnp.where(causal, diff, -jnp.inf))
    att = jnp.einsum('bihk,bjhk,bijhk->bhij', q, k, decay)
    o_intra = jnp.einsum('bhij,bjhv->bihv', att, v)
    b_last = b[:, -1]
    k_dec = k * jnp.exp(b_last[:, None] - b)
    S_new = jnp.exp(b_last)[..., None] * S + jnp.einsum('bchk,bchv->bhkv', k_dec, v)
    return S_new, o_inter + o_intra


def gla_scan(q, k, v, la, S0):
    B, L = q.shape[0], q.shape[1]
    n = -(-L // CHUNK)
    pad = n * CHUNK - L
    padf = lambda a: jnp.pad(a.astype(jnp.float32), ((0, 0), (0, pad), (0, 0), (0, 0)))
    to_chunks = lambda a: jnp.moveaxis(a.reshape(B, n, CHUNK, a.shape[2], a.shape[3]), 1, 0)
    xs = tuple(to_chunks(padf(a)) for a in (q, k, v, la))
    S_fin, o = lax.scan(gla_chunk_step, S0.astype(jnp.float32), xs)
    o = jnp.moveaxis(o, 0, 1).reshape(B, n * CHUNK, GLA_HEADS, GLA_DV)[:, :L]
    return o, S_fin


def mixer(h, conv_cache, gla_state, w_in, conv_dw_w, conv_dw_b, conv_ln_g, conv_ln_b,
          gla_gate_w2, gla_gate_b, gla_norm_g, w_out):
    B, L, _ = h.shape
    u = h @ w_in
    u_a, u_b, q, k, v, g, gz = jnp.split(u, SPLITS, axis=-1)
    y_conv, new_cc = conv_module(u_a, u_b, conv_cache, conv_dw_w, conv_dw_b, conv_ln_g, conv_ln_b)
    q = q.reshape(B, L, GLA_HEADS, GLA_DK) * (GLA_DK ** -0.5)
    k = k.reshape(B, L, GLA_HEADS, GLA_DK)
    v = v.reshape(B, L, GLA_HEADS, GLA_DV)
    la = jax.nn.log_sigmoid((gz @ gla_gate_w2 + gla_gate_b).astype(jnp.float32)) / GATE_TAU
    la = la.reshape(B, L, GLA_HEADS, GLA_DK)
    o, new_S = gla_scan(q, k, v, la, gla_state)
    o = rmsnorm(o, gla_norm_g.reshape(GLA_HEADS, GLA_DV)).astype(h.dtype)
    o = o.reshape(B, L, V_W) * jax.nn.silu(g)
    out = jnp.concatenate([y_conv, o], axis=-1) @ w_out
    return out, new_cc, new_S


def trunk(x, conv_caches, gla_states, params):
    (ffn1_norm, ffn1_w_gate, ffn1_w_up, ffn1_w_down, mix_norm, w_in, conv_dw_w, conv_dw_b,
     conv_ln_g, conv_ln_b, gla_gate_w2, gla_gate_b, gla_norm_g, w_out, ffn2_norm,
     ffn2_w_gate, ffn2_w_up, ffn2_w_down, final_norm) = params
    new_cc, new_S = [], []
    for l in range(DEPTH):
        x = x + 0.5 * swiglu(rmsnorm(x, ffn1_norm[l]), ffn1_w_gate[l], ffn1_w_up[l], ffn1_w_down[l])
        m, cc, S = mixer(rmsnorm(x, mix_norm[l]), conv_caches[l], gla_states[l], w_in[l],
                         conv_dw_w[l], conv_dw_b[l], conv_ln_g[l], conv_ln_b[l],
                         gla_gate_w2[l], gla_gate_b[l], gla_norm_g[l], w_out[l])
        x = x + m
        x = x + 0.5 * swiglu(rmsnorm(x, ffn2_norm[l]), ffn2_w_gate[l], ffn2_w_up[l], ffn2_w_down[l])
        new_cc.append(cc)
        new_S.append(S)
    return rmsnorm(x, final_norm), jnp.stack(new_cc), jnp.stack(new_S)


def setup_inputs(seed: int = 0) -> dict:
    key = jax.random.key(seed)
    ks = iter(jax.random.split(key, 32))
    nrm = lambda shape, s: jax.random.normal(next(ks), shape, jnp.float32) * s
    gain = lambda shape: 1.0 + nrm(shape, 0.02)
    return {
        "x_prompt": nrm((BATCH, SEQ, D_MODEL), 1.0),
        "x_sample": nrm((DEC_BATCH, DEC_SEQ, D_MODEL), 1.0),
        "cache_conv": nrm((DEPTH, DEC_BATCH, CONV_W - 1, C_CONV), 0.5),
        "state_gla": nrm((DEPTH, DEC_BATCH, GLA_HEADS, GLA_DK, GLA_DV), 2.0),
        "ffn1_norm": gain((DEPTH, D_MODEL)),
        "ffn1_w_gate": nrm((DEPTH, D_MODEL, D_FF), D_MODEL ** -0.5),
        "ffn1_w_up": nrm((DEPTH, D_MODEL, D_FF), D_MODEL ** -0.5),
        "ffn1_w_down": nrm((DEPTH, D_FF, D_MODEL), D_FF ** -0.5),
        "mix_norm": gain((DEPTH, D_MODEL)),
        "w_in": nrm((DEPTH, D_MODEL, IN_W), D_MODEL ** -0.5),
        "conv_dw_w": nrm((DEPTH, CONV_W, C_CONV), CONV_W ** -0.5),
        "conv_dw_b": nrm((DEPTH, C_CONV), 0.02),
        "conv_ln_g": gain((DEPTH, C_CONV)),
        "conv_ln_b": nrm((DEPTH, C_CONV), 0.02),
        "gla_gate_w2": nrm((DEPTH, GATE_RANK, QK_W), GATE_RANK ** -0.5),
        "gla_gate_b": nrm((DEPTH, QK_W), 0.1),
        "gla_norm_g": gain((DEPTH, V_W)),
        "w_out": nrm((DEPTH, MIX_WIDTH, D_MODEL), MIX_WIDTH ** -0.5),
        "ffn2_norm": gain((DEPTH, D_MODEL)),
        "ffn2_w_gate": nrm((DEPTH, D_MODEL, D_FF), D_MODEL ** -0.5),
        "ffn2_w_up": nrm((DEPTH, D_MODEL, D_FF), D_MODEL ** -0.5),
        "ffn2_w_down": nrm((DEPTH, D_FF, D_MODEL), D_FF ** -0.5),
        "final_norm": gain((D_MODEL,)),
    }


def reference(x_prompt, x_sample, cache_conv, state_gla, ffn1_norm, ffn1_w_gate, ffn1_w_up,
              ffn1_w_down, mix_norm, w_in, conv_dw_w, conv_dw_b, conv_ln_g, conv_ln_b,
              gla_gate_w2, gla_gate_b, gla_norm_g, w_out, ffn2_norm, ffn2_w_gate, ffn2_w_up,
              ffn2_w_down, final_norm):
    params = (ffn1_norm, ffn1_w_gate, ffn1_w_up, ffn1_w_down, mix_norm, w_in, conv_dw_w,
              conv_dw_b, conv_ln_g, conv_ln_b, gla_gate_w2, gla_gate_b, gla_norm_g, w_out,
              ffn2_norm, ffn2_w_gate, ffn2_w_up, ffn2_w_down, final_norm)
    B = x_prompt.shape[0]
    zero_cc = jnp.zeros((DEPTH, B, CONV_W - 1, C_CONV), x_prompt.dtype)
    zero_S = jnp.zeros((DEPTH, B, GLA_HEADS, GLA_DK, GLA_DV), jnp.float32)
    y_prompt, conv_prompt, gla_prompt = trunk(x_prompt, zero_cc, zero_S, params)
    y_sample, conv_sample, gla_sample = trunk(x_sample, cache_conv, state_gla, params)
    return (y_prompt, y_sample, conv_prompt, gla_prompt, conv_sample, gla_sample)
```

```cpp
#include <hip/hip_runtime.h>
#include <hip/hip_cooperative_groups.h>
#include <cstdio>
#include <cstdint>
namespace cg = cooperative_groups;
#ifndef MK_CG_ALL
#define MK_CG_ALL 0
#endif
namespace pg8 {
#define PG8_LAS __attribute__((address_space(3)))
typedef unsigned short bf16_t;
typedef short bf16x8 __attribute__((ext_vector_type(8)));
typedef float f32x4 __attribute__((ext_vector_type(4)));
typedef unsigned u32x4 __attribute__((ext_vector_type(4)));
constexpr int BM = 256, BK = 64, HALF = 128, HTB = HALF * BK * 2  , STAGE_BYTES = 8 * HTB, NXCD = 8, WGM = 8;

__host__ __device__ __forceinline__ int lds_byte(int r, int c) { const int st = (r >> 4) * 2 + (c >> 5), rr = r & 15, cc = c & 31, ob = rr * 64 + cc * 2; return st * 1024 + (ob ^ (((ob >> 9) & 1) << 5)); }
__host__ __device__ __forceinline__ void stage_rc(int b, int& R, int& C) { const int st = b / 1024, sb = b % 1024, swz = sb ^ (((sb >> 9) & 1) << 5); R = (st >> 1) * 16 + swz / 64; C = (st & 1) * 32 + (swz % 64) / 2; }
__host__ __device__ __forceinline__ int perm32(int rho) { const int n = rho >> 4, i = rho & 15; return 8 * (i >> 2) + 4 * n + (i & 3); }

struct Unit { int pm, pn; };
struct Gemm { const bf16_t* A; const bf16_t* Bt; int M, N, K; };

struct StaticOrder {
    int nM, nN, nwg, G, c;
    __host__ __device__ void init(int M, int N, int G_, int c_) { nM = M / BM; nN = N / BM; nwg = nM * nN; G = G_; c = c_; }
    __host__ __device__ bool next(int i, Unit& u) const {
        const long L = (long)i * G + c; if (L >= nwg) return false;
        int wgid = (int)L; { const int q = nwg / NXCD, r = nwg % NXCD, xcd = wgid % NXCD, off = wgid / NXCD; wgid = (xcd < r ? xcd * (q + 1) : r * (q + 1) + (xcd - r) * q) + off; }
        const int nig = WGM * nN, gid = wgid / nig, fm = gid * WGM, gsz = (nM - fm) < WGM ? (nM - fm) : WGM;
        u.pm = fm + ((wgid % nig) % gsz); u.pn = (wgid % nig) / gsz; return true;
    }
    __device__ __forceinline__ void a_ready(const Unit&) const {}
    __device__ __forceinline__ void done(const Unit&) const {}
};


__device__ __forceinline__ unsigned cvt_pk_bf16(float lo, float hi) { unsigned r; asm volatile("v_cvt_pk_bf16_f32 %0, %1, %2" : "=v"(r) : "v"(lo), "v"(hi)); return r; }
constexpr int DM = 1024, DFF = 2816;
__device__ __forceinline__ float row_rs(const float* ssq, int r) {
    const f32x4* p = (const f32x4*)(ssq + (size_t)r * 16);
    const f32x4 a = p[0], b = p[1], c = p[2], d = p[3];
    const f32x4 s = (a + b) + (c + d);
    return rsqrtf(((s[0] + s[1]) + (s[2] + s[3])) * (1.0f / 1024.0f) + 1e-6f);
}
__device__ __forceinline__ float sigm(float x) { return __builtin_amdgcn_rcpf(1.0f + __expf(-x)); }
__device__ __forceinline__ float silu_f(float x) { return x * sigm(x); }

struct EpiGU {
    static constexpr bool PERM = true, AFTER_DRAIN = false;
    bf16_t* H; const float* ssq;
    __device__ __forceinline__ void operator()(const f32x4 (&acc)[2][2][4][2], const Unit& u, int wr, int wc, int fr, int fq) const {
        const int row0 = u.pm * BM + wr * 64 + fr, col0 = u.pn * 128 + wc * 32 + 8 * fq;
#pragma unroll
        for (int ai = 0; ai < 2; ++ai)
#pragma unroll
            for (int m = 0; m < 4; ++m) {
                const int r = row0 + ai * HALF + m * 16; const float rs = row_rs(ssq, r);
                const f32x4 g0 = acc[ai][0][m][0] * rs, g1 = acc[ai][0][m][1] * rs, u0 = acc[ai][1][m][0] * rs, u1 = acc[ai][1][m][1] * rs;
                float h[8];
#pragma unroll
                for (int j = 0; j < 4; ++j) { h[j] = silu_f(g0[j]) * u0[j]; h[4 + j] = silu_f(g1[j]) * u1[j]; }
                u32x4 w; w.x = cvt_pk_bf16(h[0], h[1]); w.y = cvt_pk_bf16(h[2], h[3]); w.z = cvt_pk_bf16(h[4], h[5]); w.w = cvt_pk_bf16(h[6], h[7]);
                *(u32x4*)(H + (size_t)r * DFF + col0) = w;
            }
    }
};
struct EpiRes {
    static constexpr bool PERM = false, AFTER_DRAIN = false;
    const float* xin_p; const float* xin_s; float* xout; bf16_t* xb; float* ssq; float scale;
    __device__ __forceinline__ void operator()(const f32x4 (&acc)[2][2][4][2], const Unit& u, int wr, int wc, int fr, int fq) const {
        typedef unsigned u32x2 __attribute__((ext_vector_type(2)));
        const int row0 = u.pm * BM + wr * 64 + fr, col0 = u.pn * BM + wc * 32 + 4 * fq;
        const float* xin = (u.pm < 64) ? xin_p : xin_s;
#pragma unroll
        for (int ai = 0; ai < 2; ++ai)
#pragma unroll
            for (int m = 0; m < 4; ++m) {
                const int r = row0 + ai * HALF + m * 16; const size_t off = (size_t)r * DM + col0; float s = 0.f;
#pragma unroll
                for (int bj = 0; bj < 2; ++bj)
#pragma unroll
                    for (int n = 0; n < 2; ++n) {
                        const int c = bj * HALF + n * 16;
                        const f32x4 xo = *(const f32x4*)(xin + off + c);
                        const f32x4 xn = xo + acc[ai][bj][m][n] * scale;
                        *(f32x4*)(xout + off + c) = xn;
                        u32x2 w; w.x = cvt_pk_bf16(xn[0], xn[1]); w.y = cvt_pk_bf16(xn[2], xn[3]);
                        *(u32x2*)(xb + off + c) = w;
                        s += (xn[0] * xn[0] + xn[1] * xn[1]) + (xn[2] * xn[2] + xn[3] * xn[3]);
                    }
                s += __shfl_xor(s, 16); s += __shfl_xor(s, 32);
                if (fq == 0) ssq[(size_t)r * 16 + u.pn * 4 + wc] = s;
                if (m & 1) asm volatile("" ::: "memory");
            }
    }
};
struct EpiIn {
    static constexpr bool PERM = true, AFTER_DRAIN = false;
    bf16_t *Z, *Q, *K, *V, *SG; float* LA; const float* ssq; const float* gate_b;
    __device__ __forceinline__ void operator()(const f32x4 (&acc)[2][2][4][2], const Unit& u, int wr, int wc, int fr, int fq) const {
        const int row0 = u.pm * BM + wr * 64 + fr, cl0 = wc * 32 + 8 * fq, pn = u.pn;
        if (pn < 4) {
#pragma unroll
            for (int ai = 0; ai < 2; ++ai)
#pragma unroll
                for (int m = 0; m < 4; ++m) {
                    const int r = row0 + ai * HALF + m * 16; const float rs = row_rs(ssq, r);
                    const f32x4 a0 = acc[ai][0][m][0] * rs, a1 = acc[ai][0][m][1] * rs, b0 = acc[ai][1][m][0] * rs, b1 = acc[ai][1][m][1] * rs;
                    float h[8];
#pragma unroll
                    for (int j = 0; j < 4; ++j) { h[j] = a0[j] * sigm(b0[j]); h[4 + j] = a1[j] * sigm(b1[j]); }
                    u32x4 w; w.x = cvt_pk_bf16(h[0], h[1]); w.y = cvt_pk_bf16(h[2], h[3]); w.z = cvt_pk_bf16(h[4], h[5]); w.w = cvt_pk_bf16(h[6], h[7]);
                    *(u32x4*)(Z + (size_t)r * 512 + pn * 128 + cl0) = w;
                }
        } else if (pn == 10) {
            f32x4 gb[2][2];
#pragma unroll
            for (int bj = 0; bj < 2; ++bj)
#pragma unroll
                for (int n = 0; n < 2; ++n) gb[bj][n] = *(const f32x4*)(gate_b + bj * HALF + cl0 + 4 * n);
#pragma unroll
            for (int ai = 0; ai < 2; ++ai)
#pragma unroll
                for (int m = 0; m < 4; ++m) {
                    const int r = row0 + ai * HALF + m * 16; const float rs = row_rs(ssq, r);
#pragma unroll
                    for (int bj = 0; bj < 2; ++bj)
#pragma unroll
                        for (int n = 0; n < 2; ++n) {
                            const f32x4 x = acc[ai][bj][m][n] * rs + gb[bj][n]; f32x4 o;
#pragma unroll
                            for (int j = 0; j < 4; ++j) o[j] = (fminf(x[j], 0.f) - __logf(1.0f + __expf(-fabsf(x[j])))) * 0.0625f;
                            *(f32x4*)(LA + (size_t)r * 256 + bj * HALF + cl0 + 4 * n) = o;
                        }
                }
        } else {
            bf16_t* dst; int ld, cb; float sc = 1.f; const bool act = (pn >= 8);
            if (pn == 4) { dst = Q; ld = 256; cb = 0; sc = 0.125f; } else if (pn == 5) { dst = K; ld = 256; cb = 0; }
            else if (pn < 8) { dst = V; ld = 512; cb = (pn - 6) * 256; } else { dst = SG; ld = 512; cb = (pn - 8) * 256; }
#pragma unroll
            for (int ai = 0; ai < 2; ++ai)
#pragma unroll
                for (int m = 0; m < 4; ++m) {
                    const int r = row0 + ai * HALF + m * 16; const float rs = row_rs(ssq, r) * sc;
#pragma unroll
                    for (int bj = 0; bj < 2; ++bj) {
                        f32x4 v0 = acc[ai][bj][m][0] * rs, v1 = acc[ai][bj][m][1] * rs;
                        if (act) {
#pragma unroll
                            for (int j = 0; j < 4; ++j) { v0[j] = silu_f(v0[j]); v1[j] = silu_f(v1[j]); }
                        }
                        u32x4 w; w.x = cvt_pk_bf16(v0[0], v0[1]); w.y = cvt_pk_bf16(v0[2], v0[3]); w.z = cvt_pk_bf16(v1[0], v1[1]); w.w = cvt_pk_bf16(v1[2], v1[3]);
                        *(u32x4*)(dst + (size_t)r * ld + cb + bj * HALF + cl0) = w;
                    }
                }
        }
    }
};

template <class Epi, class Sched, bool ALIGN_EPI = false, bool SP2 = false>
__device__ __forceinline__ void gemm_phase(PG8_LAS unsigned char* lds, const Gemm g, const Sched& S, const Epi& E) {
    int tid_ = threadIdx.x; asm volatile("" : "+v"(tid_));
    const int tid = tid_, wid = __builtin_amdgcn_readfirstlane(tid >> 6), lane = tid & 63, wr = wid >> 2, wc = wid & 3, fr = lane & 15, fq = lane >> 4;
    const int K = g.K, nt = K / BK;
    unsigned voffA[2], voffB[2];
#pragma unroll
    for (int i = 0; i < 2; ++i) { int R, C; stage_rc(tid * 16 + i * 8192, R, C); const int Rb = Epi::PERM ? ((R & ~31) + perm32(R & 31)) : R;
        voffA[i] = (unsigned)(R * K + C) * 2u; voffB[i] = (unsigned)(Rb * K + C) * 2u; }
    const size_t kstep = (size_t)(BK * 2);
    const size_t hstep = (size_t)HALF * K * 2;
    const size_t tstep = 2 * hstep;
    const unsigned ldsw = (unsigned)wid * 1024u;
    const int aoff = lds_byte(wr * 64 + fr, fq * 8), boff = lds_byte(wc * 32 + fr, fq * 8);
#define PG8_SA(b, h) (((b) * 2 + (h)) * HTB)
#define PG8_SB(b, h) ((4 + (b) * 2 + (h)) * HTB)
#define PG8_STAGE(bufoff, gbase, voff) do { _Pragma("unroll") for (int _i = 0; _i < 2; ++_i) \
        __builtin_amdgcn_global_load_lds((const unsigned*)((const char*)(gbase) + (voff)[_i]), (PG8_LAS unsigned*)(lds + (bufoff) + ldsw + _i * 8192), 16, 0, 0); } while (0)
#define PG8_LDA(dst, b, h) do { _Pragma("unroll") for (int m = 0; m < 4; ++m) _Pragma("unroll") for (int k = 0; k < 2; ++k) dst[m][k] = *(const PG8_LAS bf16x8*)(lds + PG8_SA(b, h) + aoff + m * 2048 + k * 1024); } while (0)
#define PG8_LDB(dst, b, h) do { _Pragma("unroll") for (int n = 0; n < 2; ++n) _Pragma("unroll") for (int k = 0; k < 2; ++k) dst[n][k] = *(const PG8_LAS bf16x8*)(lds + PG8_SB(b, h) + boff + n * 2048 + k * 1024); } while (0)
#define PG8_MMA(ai, bj, At, Bt) do { __builtin_amdgcn_s_setprio(1); _Pragma("unroll") for (int m = 0; m < 4; ++m) _Pragma("unroll") for (int n = 0; n < 2; ++n) _Pragma("unroll") for (int k = 0; k < 2; ++k) \
        acc[ai][bj][m][n] = __builtin_amdgcn_mfma_f32_16x16x32_bf16(Bt[n][k], At[m][k], acc[ai][bj][m][n], 0, 0, 0); __builtin_amdgcn_s_setprio(0); } while (0)
#define PG8_WAIT_V(n) asm volatile("s_waitcnt vmcnt(" #n ")" ::: "memory")
#define PG8_WAIT_L(n) asm volatile("s_waitcnt lgkmcnt(" #n ")" ::: "memory")
#define PG8_BAR __builtin_amdgcn_s_barrier()
#define PG8_SCHED __builtin_amdgcn_sched_barrier(0)
    Unit cur, nxt; int ui = 0;
    if (!S.next(0, cur)) return;
    f32x4 acc[2][2][4][2];
#pragma unroll
    for (int a = 0; a < 2; ++a)
#pragma unroll
        for (int b = 0; b < 2; ++b)
#pragma unroll
            for (int m = 0; m < 4; ++m)
#pragma unroll
                for (int n = 0; n < 2; ++n) acc[a][b][m][n] = (f32x4){0.f, 0.f, 0.f, 0.f};
    bf16x8 At[4][2], B0[2][2], B1[2][2];
    const char* cA = (const char*)g.A + (size_t)cur.pm * tstep; const char* cB = (const char*)g.Bt + (size_t)cur.pn * tstep;
    S.a_ready(cur);
    if constexpr (SP2) {
        PG8_STAGE(PG8_SB(0, 0), cB, voffB); PG8_STAGE(PG8_SB(0, 1), cB + hstep, voffB); PG8_STAGE(PG8_SA(0, 0), cA, voffA); PG8_STAGE(PG8_SA(0, 1), cA + hstep, voffA);
        if (wr == 1) PG8_BAR;
        PG8_WAIT_V(2); PG8_BAR;
        PG8_STAGE(PG8_SB(1, 0), cB + kstep, voffB); PG8_STAGE(PG8_SA(1, 0), cA + kstep, voffA); PG8_STAGE(PG8_SB(1, 1), cB + hstep + kstep, voffB);
        PG8_WAIT_V(6); PG8_BAR;
    } else {
        PG8_STAGE(PG8_SB(0, 0), cB, voffB); PG8_STAGE(PG8_SA(0, 0), cA, voffA); PG8_STAGE(PG8_SB(0, 1), cB + hstep, voffB); PG8_STAGE(PG8_SA(0, 1), cA + hstep, voffA);
        if (wr == 1) PG8_BAR;
        PG8_WAIT_V(4); PG8_BAR;
        PG8_STAGE(PG8_SB(1, 0), cB + kstep, voffB); PG8_STAGE(PG8_SA(1, 0), cA + kstep, voffA); PG8_STAGE(PG8_SB(1, 1), cB + hstep + kstep, voffB);
        PG8_WAIT_V(6); PG8_BAR;
    }
    for (;;) {
        const bool has_next = S.next(ui + 1, nxt);
        const char* nA = has_next ? (const char*)g.A + (size_t)nxt.pm * tstep : cA; const char* nB = has_next ? (const char*)g.Bt + (size_t)nxt.pn * tstep : cB;
        for (int t = 0; t < nt; t += 2) {
            const bool last = (t == nt - 2);
            const char* a1 = cA + (size_t)(t + 1) * kstep;
            const char* a2 = last ? nA : cA + (size_t)(t + 2) * kstep; const char* b2 = last ? nB : cB + (size_t)(t + 2) * kstep;
            const char* a3 = a2 + kstep; const char* b3 = b2 + kstep;
            if (last && has_next) S.a_ready(nxt);
            if constexpr (SP2) {
            PG8_LDB(B0, 0, 0); PG8_LDB(B1, 0, 1); PG8_SCHED; PG8_LDA(At, 0, 0); PG8_STAGE(PG8_SA(1, 1), a1 + hstep, voffA);
            PG8_WAIT_V(8); PG8_WAIT_L(0); PG8_BAR; PG8_MMA(0, 0, At, B0); PG8_MMA(0, 1, At, B1); PG8_BAR; PG8_SCHED;
            PG8_LDA(At, 0, 1); PG8_STAGE(PG8_SB(0, 0), b2, voffB); PG8_STAGE(PG8_SB(0, 1), b2 + hstep, voffB); PG8_STAGE(PG8_SA(0, 0), a2, voffA);
            PG8_WAIT_V(8); PG8_WAIT_L(0); PG8_BAR; PG8_MMA(1, 0, At, B0); PG8_MMA(1, 1, At, B1); PG8_BAR; PG8_SCHED;
            PG8_LDB(B0, 1, 0); PG8_LDB(B1, 1, 1); PG8_SCHED; PG8_LDA(At, 1, 0); PG8_STAGE(PG8_SA(0, 1), a2 + hstep, voffA);
            PG8_WAIT_V(8); PG8_WAIT_L(0); PG8_BAR; PG8_MMA(0, 0, At, B0); PG8_MMA(0, 1, At, B1); PG8_BAR; PG8_SCHED;
            PG8_LDA(At, 1, 1); PG8_STAGE(PG8_SB(1, 0), b3, voffB); PG8_STAGE(PG8_SB(1, 1), b3 + hstep, voffB); PG8_STAGE(PG8_SA(1, 0), a3, voffA);
            PG8_WAIT_V(8); PG8_WAIT_L(0); PG8_BAR; PG8_MMA(1, 0, At, B0); PG8_MMA(1, 1, At, B1); PG8_BAR; PG8_SCHED;
            } else {
            PG8_LDB(B0, 0, 0); PG8_SCHED; PG8_LDA(At, 0, 0); PG8_STAGE(PG8_SA(1, 1), a1 + hstep, voffA);
            PG8_WAIT_L(8); PG8_BAR; PG8_WAIT_L(0); PG8_MMA(0, 0, At, B0); PG8_BAR; PG8_SCHED;
            PG8_LDB(B1, 0, 1); PG8_STAGE(PG8_SB(0, 0), b2, voffB);
            PG8_BAR; PG8_WAIT_L(0); PG8_MMA(0, 1, At, B1); PG8_BAR;
            PG8_LDA(At, 0, 1); PG8_STAGE(PG8_SA(0, 0), a2, voffA);
            PG8_BAR; PG8_WAIT_L(0); PG8_MMA(1, 0, At, B0); PG8_BAR; PG8_SCHED;
            PG8_STAGE(PG8_SB(0, 1), b2 + hstep, voffB);
            PG8_WAIT_V(6); PG8_BAR; PG8_MMA(1, 1, At, B1); PG8_BAR;
            PG8_LDB(B0, 1, 0); PG8_SCHED; PG8_LDA(At, 1, 0); PG8_STAGE(PG8_SA(0, 1), a2 + hstep, voffA);
            PG8_WAIT_L(8); PG8_BAR; PG8_WAIT_L(0); PG8_MMA(0, 0, At, B0); PG8_BAR; PG8_SCHED;
            PG8_LDB(B1, 1, 1); PG8_STAGE(PG8_SB(1, 0), b3, voffB);
            PG8_BAR; PG8_WAIT_L(0); PG8_MMA(0, 1, At, B1); PG8_BAR;
            PG8_LDA(At, 1, 1); PG8_STAGE(PG8_SA(1, 0), a3, voffA);
            PG8_BAR; PG8_WAIT_L(0); PG8_MMA(1, 0, At, B0); PG8_BAR; PG8_SCHED;
            PG8_STAGE(PG8_SB(1, 1), b3 + hstep, voffB);
            PG8_WAIT_V(6); PG8_BAR; PG8_MMA(1, 1, At, B1); PG8_BAR;
            }
        }
        if constexpr (ALIGN_EPI) { if (wr == 0) PG8_BAR; }
        if constexpr (!Epi::AFTER_DRAIN) { E(acc, cur, wr, wc, fr, fq); S.done(cur); }
        if (!has_next) break;
#pragma unroll
        for (int a = 0; a < 2; ++a)
#pragma unroll
            for (int b = 0; b < 2; ++b)
#pragma unroll
                for (int m = 0; m < 4; ++m)
#pragma unroll
                    for (int n = 0; n < 2; ++n) acc[a][b][m][n] = (f32x4){0.f, 0.f, 0.f, 0.f};
        cur = nxt; cA = nA; cB = nB; ++ui;
        if constexpr (ALIGN_EPI) { if (wr == 1) PG8_BAR; }
    }
    PG8_WAIT_V(0);
    if constexpr (!ALIGN_EPI) { if (wr == 0) PG8_BAR; }
    PG8_BAR;
    if constexpr (Epi::AFTER_DRAIN) { E.fused(acc, cur, wr, wc, fr, fq, lds, wid, lane); S.done(cur); }
#undef PG8_SA
#undef PG8_SB
#undef PG8_STAGE
#undef PG8_LDA
#undef PG8_LDB
#undef PG8_MMA
#undef PG8_WAIT_V
#undef PG8_WAIT_L
#undef PG8_BAR
#undef PG8_SCHED
}
}
#define GAS __attribute__((address_space(1)))
#define LAS __attribute__((address_space(3)))
typedef unsigned short bf16;
typedef unsigned v4u __attribute__((ext_vector_type(4)));
typedef float f32x4 __attribute__((ext_vector_type(4)));
typedef short bf16x8 __attribute__((ext_vector_type(8)));
typedef GAS unsigned gu32;
typedef GAS unsigned long long gu64;
#define RLX_AGENT __ATOMIC_RELAXED, __HIP_MEMORY_SCOPE_AGENT
#define LDS_WAIT() asm volatile("s_waitcnt lgkmcnt(0)" ::: "memory")
#define VM_WAIT() asm volatile("s_waitcnt vmcnt(0)" ::: "memory")
__device__ __forceinline__ unsigned long long rt() { return __builtin_amdgcn_s_memrealtime(); }
__device__ __forceinline__ unsigned f2bf(float f) { unsigned u = __builtin_bit_cast(unsigned, f); return (u + 0x7fffu + ((u >> 16) & 1u)) >> 16; }
__device__ __forceinline__ unsigned pk2(float lo, float hi) { return f2bf(lo) | (f2bf(hi) << 16); }

#define XB_TMO      128
#define XB_XCNT(j)  (256  + 64 * (j))
#define XB_XSUB(j)  (1280 + 64 * (j))
#define XB_XGEN(j)  (2304 + 64 * (j))
#define XB_TOP      3328
#define XB_TOPGEN   3392
#define XCD_BAR_WORDS 3456
#define XB_SPIN_CAP (1u << 18)

__device__ __forceinline__ unsigned xb_ld(unsigned* p)              { return __hip_atomic_load(p, __ATOMIC_RELAXED, __HIP_MEMORY_SCOPE_AGENT); }
__device__ __forceinline__ unsigned xb_add(unsigned* p, unsigned v) { return __hip_atomic_fetch_add(p, v, __ATOMIC_RELAXED, __HIP_MEMORY_SCOPE_AGENT); }
__device__ __forceinline__ unsigned xb_xcc_id() { return (unsigned)__builtin_amdgcn_s_getreg((3 << 11) | 20) & 0xFu; }
#define XB_SPIN(cond, bar) do { unsigned _sp = 0; while (cond) { __builtin_amdgcn_s_sleep(1); \
    if ((++_sp & 255u) == 0u) { if (xb_ld(&(bar)[XB_TMO])) break; if (_sp > XB_SPIN_CAP) { atomicAdd(&(bar)[XB_TMO], 1u); break; } } } } while (0)

struct XcdBarrier {
    unsigned* bar; unsigned x;
    volatile LAS unsigned* st;
};

__device__ __forceinline__ XcdBarrier xcd_barrier_post(unsigned* bar, volatile LAS unsigned* st) {
    XcdBarrier b; b.bar = bar; b.x = xb_xcc_id(); b.st = st;
    if (threadIdx.x == 0) (void)xb_add(&bar[XB_XCNT(b.x)], 1u);
    return b;
}
__device__ __forceinline__ void xcd_barrier_complete(unsigned* bar, unsigned x, unsigned& nloc, unsigned& nx) {
    const unsigned G = gridDim.x * gridDim.y * gridDim.z;
    unsigned sum, cnt, mine, sp = 0u;
    for (;;) {
        sum = 0u; cnt = 0u; mine = 0u;
#pragma unroll
        for (unsigned j = 0; j < 16; ++j) { const unsigned c = xb_ld(&bar[XB_XCNT(j)]); sum += c; cnt += (c > 0u) ? 1u : 0u; mine = (j == x) ? c : mine; }
        if (sum == G) break;
        __builtin_amdgcn_s_sleep(1);
        if ((++sp & 255u) == 0u) { if (xb_ld(&bar[XB_TMO])) break; if (sp > XB_SPIN_CAP) { atomicAdd(&bar[XB_TMO], 1u); break; } }
    }
    nloc = mine > 0u ? mine : 1u; nx = cnt > 0u ? cnt : 1u;
}

__device__ __forceinline__ void xcd_barrier(const XcdBarrier& b) {
    asm volatile("s_waitcnt vmcnt(0)" ::: "memory");
    __syncthreads();
    if (threadIdx.x == 0) {
        unsigned* bar = b.bar;
        __builtin_amdgcn_s_waitcnt(0);
        unsigned nloc = b.st[0], nx = b.st[1];
        if (nloc == 0u) { xcd_barrier_complete(bar, b.x, nloc, nx); b.st[0] = nloc; b.st[1] = nx; }
        const unsigned old = xb_add(&bar[XB_XSUB(b.x)], 1u);
        const unsigned gen = old / nloc;
        if (old + 1u == (gen + 1u) * nloc) {
            __builtin_amdgcn_fence(__ATOMIC_RELEASE, "agent");
            asm volatile("s_waitcnt vmcnt(0)" ::: "memory");
            const unsigned og = xb_add(&bar[XB_TOP], 1u);
            const unsigned tg = og / nx;
            if (og + 1u == (tg + 1u) * nx) xb_add(&bar[XB_TOPGEN], 1u);
            else XB_SPIN(xb_ld(&bar[XB_TOPGEN]) == tg, bar);
            __builtin_amdgcn_fence(__ATOMIC_ACQUIRE, "agent");
            xb_add(&bar[XB_XGEN(b.x)], 1u);
            asm volatile("s_waitcnt vmcnt(0)" ::: "memory");
        } else {
            XB_SPIN(xb_ld(&bar[XB_XGEN(b.x)]) == gen, bar);
            __builtin_amdgcn_fence(__ATOMIC_ACQUIRE, "agent");
            asm volatile("s_waitcnt vmcnt(0)" ::: "memory");
        }
    }
    __syncthreads();
}

constexpr int NWAVES = 8;
constexpr int D = 1024, FF = 2816, NL = 2;
constexpr int M_P = 4 * 4096, M_S = 32 * 64, M = M_P + M_S;
constexpr int NCH = M / 64, NCH_P = M_P / 64;
constexpr int IN_W = 2576, NIN = 2816;
constexpr size_t OFF_Y = 0, OFF_CONV_P = (size_t)M * D, OFF_GLA_P = OFF_CONV_P + 2 * 4 * 30 * 512, OFF_CONV_S = OFF_GLA_P + 2 * 4 * 4 * 64 * 128,
                 OFF_GLA_S = OFF_CONV_S + 2 * 32 * 30 * 512, OUT_END = OFF_GLA_S + 2 * 32 * 4 * 64 * 128;
constexpr size_t MiB = 1u << 20;
constexpr size_t WS_CTL = 0, CTL_ZERO_BYTES = 65536;
constexpr size_t WS_SSQ = 1 * MiB;
constexpr size_t WS_DEC = 3 * MiB;
constexpr size_t WS_W = 4 * MiB;
constexpr size_t WE_GU1 = 0, WE_D1 = WE_GU1 + (size_t)2 * FF * D, WE_IN = WE_D1 + (size_t)D * FF, WE_OUT = WE_IN + (size_t)NIN * D, WE_GU2 = WE_OUT + (size_t)D * D,
                 WE_D2 = WE_GU2 + (size_t)2 * FF * D, WE_END = WE_D2 + (size_t)D * FF;
constexpr size_t WS_XB = 45 * MiB;
constexpr size_t WS_R = 81 * MiB;
constexpr size_t WS_HID = WS_R;
constexpr size_t WS_Z = WS_R, WS_Q = WS_Z + 18 * MiB, WS_K = WS_Q + 9 * MiB, WS_V = WS_K + 9 * MiB, WS_SG = WS_V + 18 * MiB, WS_LA = WS_SG + 18 * MiB;
constexpr size_t WS_CAT = WS_R + 90 * MiB;
constexpr size_t WS_ST = WS_CAT + 36 * MiB;
constexpr size_t WS_END = WS_ST + 32 * MiB;
static_assert(WS_W + WE_END * 2 <= WS_XB && WS_XB + (size_t)M * D * 2 <= WS_R && WS_HID + (size_t)M * FF * 2 <= WS_END && WS_LA + (size_t)M * 256 * 4 <= WS_CAT, "d_ws map");
constexpr int CW_BAR = 4096;
constexpr int RING_BYTES = 131072, LDSCTL_OFF = RING_BYTES, MISC_OFF = LDSCTL_OFF + 320, LDS_BYTES = 147456;

constexpr int PT_OFF = MISC_OFF + 128;
enum { P_XP = 0, P_XS, P_CC, P_ST0, P_F1N, P_F1G, P_F1U, P_F1D, P_MN, P_WIN, P_DWW, P_DWB, P_LNG, P_LNB, P_GW2, P_GB, P_GNG, P_WOUT, P_F2N, P_F2G, P_F2U, P_F2D, P_FN, P_OUT, P_WS, P_COUNT };
static_assert(PT_OFF + P_COUNT * 8 <= LDS_BYTES, "LDS map");
struct Frame { LAS unsigned char* lds; int G; };
#define PHASE_IDS() int tid_ = threadIdx.x; asm volatile("" : "+v"(tid_)); const int tid = tid_, lane = tid & 63, wave = __builtin_amdgcn_readfirstlane(tid >> 6); (void)lane; (void)wave
__device__ __forceinline__ unsigned long long ldp_raw(const Frame& F, int i) {
    const volatile LAS unsigned* t = (const volatile LAS unsigned*)(F.lds + PT_OFF) + 2 * i;
    const unsigned lo = __builtin_amdgcn_readfirstlane(t[0]), hi = __builtin_amdgcn_readfirstlane(t[1]);
    return ((unsigned long long)hi << 32) | lo;
}
__device__ __forceinline__ const float* ldp(const Frame& F, int i) { return (const float*)ldp_raw(F, i); }
__device__ __forceinline__ float* outp(const Frame& F) { return (float*)ldp_raw(F, P_OUT); }
__device__ __forceinline__ unsigned char* wsp(const Frame& F) { return (unsigned char*)ldp_raw(F, P_WS); }
__device__ __forceinline__ float wave_sum(float v) {
#pragma unroll
    for (int o = 1; o < 64; o <<= 1) v += __shfl_xor(v, o);
    return v;
}
__device__ __forceinline__ float bf2f(bf16 h) { return __builtin_bit_cast(float, (unsigned)h << 16); }

__device__ __forceinline__ void tr_store(LAS float* scr, bf16* WT, int ldk, int drow0, int k0, int lane) {
    LDS_WAIT(); asm volatile("" ::: "memory");
    const int c = lane & 7;
#pragma unroll
    for (int j = 0; j < 4; ++j) { const int n = (lane >> 3) + 8 * j; const LAS float* s = scr + (8 * c) * 33 + n;
        v4u o; o.x = pk2(s[0 * 33], s[1 * 33]); o.y = pk2(s[2 * 33], s[3 * 33]); o.z = pk2(s[4 * 33], s[5 * 33]); o.w = pk2(s[6 * 33], s[7 * 33]);
        *(GAS v4u*)(WT + (size_t)(drow0 + n) * ldk + k0 + 8 * c) = o; }
    LDS_WAIT(); asm volatile("" ::: "memory");
}
__device__ __forceinline__ void tr_item(const float* W, int ldn, int k0, int n0, const float* gain, bf16* WT, int ldk, int drow0, LAS float* scr, int lane) {
#pragma unroll 8
    for (int i = 0; i < 32; ++i) { const int kk = 2 * i + (lane >> 5); float v = W[(size_t)(k0 + kk) * ldn + n0 + (lane & 31)]; if (gain) v *= gain[k0 + kk]; scr[kk * 33 + (lane & 31)] = v; }
    tr_store(scr, WT, ldk, drow0, k0, lane);
}
__device__ __forceinline__ void la_item(const float* Win, const float* w2, int k0, int n0, const float* gain, bf16* WT, int drow0, LAS float* scr, int lane) {
    float wc[16];
#pragma unroll
    for (int r = 0; r < 16; ++r) wc[r] = w2[r * 256 + n0 + (lane & 31)];
#pragma unroll 4
    for (int i = 0; i < 32; ++i) { const int kk = 2 * i + (lane >> 5); const float* wr_ = Win + (size_t)(k0 + kk) * IN_W + 2560; float a = 0.f;
#pragma unroll
        for (int r = 0; r < 16; ++r) a += wr_[r] * wc[r];
        scr[kk * 33 + (lane & 31)] = a * gain[k0 + kk]; }
    tr_store(scr, WT, D, drow0, k0, lane);
}
__device__ __forceinline__ void convert_phase(Frame& F, int l) {
    PHASE_IDS();
    unsigned char* const ws_ = wsp(F);
    const float* const ffn1_norm = ldp(F, P_F1N);
    const float* const ffn1_wg = ldp(F, P_F1G);
    const float* const ffn1_wu = ldp(F, P_F1U);
    const float* const ffn1_wd = ldp(F, P_F1D);
    const float* const mix_norm = ldp(F, P_MN);
    const float* const w_in = ldp(F, P_WIN);
    const float* const gate_w2 = ldp(F, P_GW2);
    const float* const w_out = ldp(F, P_WOUT);
    const float* const ffn2_norm = ldp(F, P_F2N);
    const float* const ffn2_wg = ldp(F, P_F2G);
    const float* const ffn2_wu = ldp(F, P_F2U);
    const float* const ffn2_wd = ldp(F, P_F2D);
    bf16* const W = (bf16*)(ws_ + WS_W);
    LAS float* scr = (LAS float*)(F.lds) + wave * 4096;
    const int gw = blockIdx.x * NWAVES + wave, NGW = F.G * NWAVES;
    constexpr int I_G = 16 * 88, I_D = 44 * 32, I_IN = 16 * 80, I_LA = 16 * 8, I_O = 16 * 32, NIT = 4 * I_G + 2 * I_D + I_IN + I_LA + I_O;
    const size_t lw = (size_t)l * D * FF;
    for (int it = gw; it < NIT; it += NGW) {
        int r = it;
        if (r < 4 * I_G) {
            const int sel = r / I_G; r -= sel * I_G; const int kb = r / 88, nb = r % 88, n0 = 32 * nb, which = sel & 1;
            const float* Wsrc = (sel == 0 ? ffn1_wg : sel == 1 ? ffn1_wu : sel == 2 ? ffn2_wg : ffn2_wu) + lw;
            const float* gain = (sel < 2 ? ffn1_norm : ffn2_norm) + l * D;
            tr_item(Wsrc, FF, 64 * kb, n0, gain, W + (sel < 2 ? WE_GU1 : WE_GU2), D, 256 * (n0 >> 7) + 128 * which + (n0 & 127), scr, lane); continue; }
        r -= 4 * I_G;
        if (r < 2 * I_D) { const int sel = r / I_D; r -= sel * I_D; const int kb = r / 32, nb = r % 32;
            tr_item((sel ? ffn2_wd : ffn1_wd) + lw, D, 64 * kb, 32 * nb, nullptr, W + (sel ? WE_D2 : WE_D1), FF, 32 * nb, scr, lane); continue; }
        r -= 2 * I_D;
        if (r < I_IN) { const int kb = r / 80, nb = r % 80, n0 = 32 * nb; int dr = n0;
            if (n0 < 512) dr = 256 * (n0 >> 7) + (n0 & 127); else if (n0 < 1024) dr = 256 * ((n0 - 512) >> 7) + 128 + (n0 & 127);
            tr_item(w_in + (size_t)l * D * IN_W, IN_W, 64 * kb, n0, mix_norm + l * D, W + WE_IN, D, dr, scr, lane); continue; }
        r -= I_IN;
        if (r < I_LA) { const int kb = r / 8, nb = r % 8;
            la_item(w_in + (size_t)l * D * IN_W, gate_w2 + l * 16 * 256, 64 * kb, 32 * nb, mix_norm + l * D, W + WE_IN, 2560 + 32 * nb, scr, lane); continue; }
        r -= I_LA;
        { const int kb = r / 32, nb = r % 32; tr_item(w_out + (size_t)l * D * D, D, 64 * kb, 32 * nb, nullptr, W + WE_OUT, D, 32 * nb, scr, lane); }
    }
}
__device__ __forceinline__ void prep_phase(Frame& F) {
    PHASE_IDS();
    unsigned char* const ws_ = wsp(F);
    const float* const x_prompt = ldp(F, P_XP);
    const float* const x_sample = ldp(F, P_XS);
    float* const SSQ = (float*)(ws_ + WS_SSQ);
    bf16* const XB = (bf16*)(ws_ + WS_XB);
    const int gw = blockIdx.x * NWAVES + wave, NGW = F.G * NWAVES;
    for (int m = gw; m < M; m += NGW) {
        const float* xrow = (m < M_P) ? x_prompt + (size_t)m * D : x_sample + (size_t)(m - M_P) * D;
        const f32x4* xr = (const f32x4*)xrow + lane; f32x4 v[4]; float s = 0.f;
#pragma unroll
        for (int j = 0; j < 4; ++j) { v[j] = xr[64 * j]; s += (v[j].x * v[j].x + v[j].y * v[j].y) + (v[j].z * v[j].z + v[j].w * v[j].w); }
        s = wave_sum(s);
        unsigned long long* o8 = (unsigned long long*)(XB + (size_t)m * D) + lane;
#pragma unroll
        for (int j = 0; j < 4; ++j) o8[64 * j] = (unsigned long long)pk2(v[j].x, v[j].y) | ((unsigned long long)pk2(v[j].z, v[j].w) << 32);
        if (lane < 16) SSQ[(size_t)m * 16 + lane] = (lane == 0) ? s : 0.f;
    }
}
__device__ __forceinline__ void conv_phase(Frame& F, int l) {
    PHASE_IDS();
    unsigned char* const ws_ = wsp(F);
    const float* const cache_conv = ldp(F, P_CC);
    const float* const conv_dw_w = ldp(F, P_DWW);
    const float* const conv_dw_b = ldp(F, P_DWB);
    const float* const conv_ln_g = ldp(F, P_LNG);
    const float* const conv_ln_b = ldp(F, P_LNB);
    bf16* const Z = (bf16*)(ws_ + WS_Z);
    bf16* const CAT = (bf16*)(ws_ + WS_CAT);
    float* const out = outp(F);
    const int c = tid;
    LAS float* sY = (LAS float*)F.lds;
    LAS float* sStat = sY + 16 * 512;
    float w[31];
#pragma unroll
    for (int i = 0; i < 31; ++i) w[i] = conv_dw_w[(size_t)(l * 31 + i) * 512 + c];
    const float bias = conv_dw_b[l * 512 + c], lg = conv_ln_g[l * 512 + c], lb = conv_ln_b[l * 512 + c];
    for (int tile = blockIdx.x; tile < M / 16; tile += F.G) {
        const int m0 = tile * 16; int ms; const float* cache = nullptr;
        if (m0 < M_P) ms = m0 & ~4095; else { const int s = (m0 - M_P) >> 6; ms = M_P + s * 64; cache = cache_conv + (size_t)(l * 32 + s) * 30 * 512; }
        const int t0 = m0 - ms;
        float zv[46];
#pragma unroll
        for (int j = 0; j < 46; ++j) { const int t = t0 - 30 + j; float v = 0.f;
            if (t >= 0) v = bf2f(Z[(size_t)(ms + t) * 512 + c]); else if (cache) v = cache[(30 + t) * 512 + c];
            zv[j] = v; }
        float y[16];
#pragma unroll
        for (int i = 0; i < 16; ++i) { float a = bias;
#pragma unroll
            for (int k = 0; k < 31; ++k) a += w[k] * zv[i + k];
            y[i] = a; sY[i * 512 + c] = a; }
        __syncthreads();
#pragma unroll
        for (int q = 0; q < 2; ++q) { const int i = 2 * wave + q; float v[8]; float s = 0.f;
#pragma unroll
            for (int k = 0; k < 8; ++k) { v[k] = sY[i * 512 + lane + 64 * k]; s += v[k]; }
            const float mean = wave_sum(s) * (1.f / 512.f); float s2 = 0.f;
#pragma unroll
            for (int k = 0; k < 8; ++k) { const float d = v[k] - mean; s2 += d * d; }
            const float rstd = rsqrtf(wave_sum(s2) * (1.f / 512.f) + 1e-6f);
            if (lane == 0) { sStat[2 * i] = mean; sStat[2 * i + 1] = rstd; } }
        __syncthreads();
#pragma unroll
        for (int i = 0; i < 16; ++i) { const float mean = sStat[2 * i], rstd = sStat[2 * i + 1]; float o = (y[i] - mean) * rstd * lg + lb; o = o * __builtin_amdgcn_rcpf(1.f + __expf(-o));
            CAT[(size_t)(m0 + i) * D + c] = (bf16)f2bf(o); }
        __syncthreads();
    }
    for (int rr = blockIdx.x; rr < 36 * 30; rr += F.G) { const int sq = rr / 30, r = rr % 30;
        if (sq < 4) out[OFF_CONV_P + ((size_t)(l * 4 + sq) * 30 + r) * 512 + c] = bf2f(Z[(size_t)(sq * 4096 + 4066 + r) * 512 + c]);
        else { const int s = sq - 4; out[OFF_CONV_S + ((size_t)(l * 32 + s) * 30 + r) * 512 + c] = bf2f(Z[(size_t)(M_P + s * 64 + 34 + r) * 512 + c]); } }
}
__device__ __forceinline__ void gla1_phase(Frame& F, int l) {
    PHASE_IDS();
    unsigned char* const ws_ = wsp(F);
    const float* const state_gla = ldp(F, P_ST0);
    float* const DEC = (float*)(ws_ + WS_DEC);
    float* const LA = (float*)(ws_ + WS_LA);
    float* const ST = (float*)(ws_ + WS_ST);
    bf16* const K = (bf16*)(ws_ + WS_K);
    bf16* const V = (bf16*)(ws_ + WS_V);
    float* const out = outp(F);
    LAS float* sB = (LAS float*)F.lds;
    LAS float* sK = sB + 64 * 64;
    LAS float* sV = sK + 64 * 64;
    for (int item = blockIdx.x; item < NCH * 4; item += F.G) {
        const int ch = item >> 2, h = item & 3; const size_t m0 = (size_t)ch * 64;
        for (int e = tid; e < 4096; e += 512) { const int j = e >> 6, k = e & 63; sB[e] = LA[(m0 + j) * 256 + h * 64 + k]; }
        __syncthreads();
        if (tid < 64) { float b = 0.f;
            for (int j = 0; j < 64; ++j) { b += sB[j * 64 + tid]; sB[j * 64 + tid] = b; } }
        __syncthreads();
        for (int e = tid; e < 4096; e += 512) { const int j = e >> 6, k = e & 63; sK[e] = bf2f(K[(m0 + j) * 256 + h * 64 + k]) * __expf(-sB[e]); }
        for (int e = tid; e < 8192; e += 512) { const int j = e >> 7, v = e & 127; sV[e] = bf2f(V[(m0 + j) * 512 + h * 128 + v]); }
        __syncthreads();
        const int v = tid & 127, kg = tid >> 7;
        float acc[16];
#pragma unroll
        for (int i = 0; i < 16; ++i) acc[i] = 0.f;
        for (int j = 0; j < 64; ++j) { const float sv = sV[j * 128 + v];
#pragma unroll
            for (int i = 0; i < 16; ++i) acc[i] += sK[j * 64 + kg * 16 + i] * sv; }
#pragma unroll
        for (int i = 0; i < 16; ++i) { const int k = kg * 16 + i; const float dec = __expf(sB[63 * 64 + k]);
            if (ch < NCH_P) { ST[(((size_t)ch * 4 + h) * 64 + k) * 128 + v] = dec * acc[i]; if (v == 0) DEC[(ch * 4 + h) * 64 + k] = dec; }
            else { const size_t idx = (((size_t)(l * 32 + (ch - NCH_P)) * 4 + h) * 64 + k) * 128 + v; out[OFF_GLA_S + idx] = dec * (state_gla[idx] + acc[i]); } }
        __syncthreads();
    }
}
__device__ __forceinline__ void scan_phase(Frame& F, int l) {
    PHASE_IDS();
    unsigned char* const ws_ = wsp(F);
    float* const DEC = (float*)(ws_ + WS_DEC);
    float* const ST = (float*)(ws_ + WS_ST);
    float* const out = outp(F);
    for (int e = blockIdx.x * 512 + tid; e < 4 * 4 * 64 * 128; e += F.G * 512) {
        const int v = e & 127, k = (e >> 7) & 63, h = (e >> 13) & 3, b = e >> 15; float S = 0.f;
        for (int c = 0; c < 64; ++c) { const int ch = b * 64 + c; const size_t idx = (((size_t)ch * 4 + h) * 64 + k) * 128 + v;
            const float d = ST[idx], dec = DEC[(ch * 4 + h) * 64 + k]; ST[idx] = S; S = dec * S + d; }
        out[OFF_GLA_P + (((size_t)(l * 4 + b) * 4 + h) * 64 + k) * 128 + v] = S;
    }
}
__device__ __forceinline__ void gla2_phase(Frame& F, int l) {
    PHASE_IDS();
    unsigned char* const ws_ = wsp(F);
    const float* const state_gla = ldp(F, P_ST0);
    const float* const gla_norm_g = ldp(F, P_GNG);
    float* const LA = (float*)(ws_ + WS_LA);
    float* const ST = (float*)(ws_ + WS_ST);
    bf16* const Q = (bf16*)(ws_ + WS_Q);
    bf16* const K = (bf16*)(ws_ + WS_K);
    bf16* const V = (bf16*)(ws_ + WS_V);
    bf16* const SG = (bf16*)(ws_ + WS_SG);
    bf16* const CAT = (bf16*)(ws_ + WS_CAT);
    LAS float* sQ = (LAS float*)F.lds;
    LAS float* sK = sQ + 64 * 68;
    LAS float* sA = sK + 64 * 68;
    LAS float* sV = sA + 64 * 68;
    LAS float* sS = sV + 64 * 128;
    for (int item = blockIdx.x; item < NCH * 4; item += F.G) {
        const int ch = item >> 2, h = item & 3; const size_t m0 = (size_t)ch * 64;
        for (int e = tid; e < 4096; e += 512) { const int j = e >> 6, k = e & 63; sA[j * 68 + k] = LA[(m0 + j) * 256 + h * 64 + k]; }
        __syncthreads();
        if (tid < 64) { float b = 0.f;
            for (int j = 0; j < 64; ++j) { b += sA[j * 68 + tid]; sA[j * 68 + tid] = b; } }
        __syncthreads();
        for (int e = tid; e < 4096; e += 512) { const int j = e >> 6, k = e & 63; const float b = sA[j * 68 + k];
            sQ[j * 68 + k] = bf2f(Q[(m0 + j) * 256 + h * 64 + k]) * __expf(b); sK[j * 68 + k] = bf2f(K[(m0 + j) * 256 + h * 64 + k]) * __expf(-b); }
        const float* Sb = (ch < NCH_P) ? ST + ((size_t)ch * 4 + h) * 8192 : state_gla + ((size_t)(l * 32 + (ch - NCH_P)) * 4 + h) * 8192;
        for (int e = tid; e < 8192; e += 512) { const int j = e >> 7, v = e & 127; sV[e] = bf2f(V[(m0 + j) * 512 + h * 128 + v]); sS[e] = Sb[e]; }
        __syncthreads();
        {
            const int i = tid >> 3, jg = tid & 7; float a[8];
#pragma unroll
            for (int jj = 0; jj < 8; ++jj) a[jj] = 0.f;
            for (int k4 = 0; k4 < 16; ++k4) { const f32x4 q4 = *(const LAS f32x4*)(sQ + i * 68 + 4 * k4);
#pragma unroll
                for (int jj = 0; jj < 8; ++jj) { const f32x4 kv = *(const LAS f32x4*)(sK + (jg + 8 * jj) * 68 + 4 * k4); a[jj] += (q4.x * kv.x + q4.y * kv.y) + (q4.z * kv.z + q4.w * kv.w); } }
#pragma unroll
            for (int jj = 0; jj < 8; ++jj) { const int j = jg + 8 * jj; sA[i * 68 + j] = (j <= i) ? a[jj] : 0.f; }
        }
        __syncthreads();
        const int v = tid & 127, ig = tid >> 7;
        float acc[16];
#pragma unroll
        for (int ii = 0; ii < 16; ++ii) acc[ii] = 0.f;
        for (int k4 = 0; k4 < 16; ++k4) { const float s0 = sS[(4 * k4 + 0) * 128 + v], s1 = sS[(4 * k4 + 1) * 128 + v], s2 = sS[(4 * k4 + 2) * 128 + v], s3 = sS[(4 * k4 + 3) * 128 + v];
#pragma unroll
            for (int ii = 0; ii < 16; ++ii) { const f32x4 q4 = *(const LAS f32x4*)(sQ + (ig * 16 + ii) * 68 + 4 * k4); acc[ii] += (q4.x * s0 + q4.y * s1) + (q4.z * s2 + q4.w * s3); } }
        for (int j4 = 0; j4 < 16; ++j4) { const float s0 = sV[(4 * j4 + 0) * 128 + v], s1 = sV[(4 * j4 + 1) * 128 + v], s2 = sV[(4 * j4 + 2) * 128 + v], s3 = sV[(4 * j4 + 3) * 128 + v];
#pragma unroll
            for (int ii = 0; ii < 16; ++ii) { const f32x4 a4 = *(const LAS f32x4*)(sA + (ig * 16 + ii) * 68 + 4 * j4); acc[ii] += (a4.x * s0 + a4.y * s1) + (a4.z * s2 + a4.w * s3); } }
        __syncthreads();
#pragma unroll
        for (int ii = 0; ii < 16; ++ii) sS[(ig * 16 + ii) * 128 + v] = acc[ii];
        __syncthreads();
#pragma unroll
        for (int q = 0; q < 8; ++q) { const int i = 8 * wave + q; const float o0 = sS[i * 128 + lane], o1 = sS[i * 128 + 64 + lane];
            const float rs = rsqrtf(wave_sum(o0 * o0 + o1 * o1) * (1.f / 128.f) + 1e-6f); const size_t m = m0 + i; const int c0 = h * 128 + lane;
            CAT[m * D + 512 + c0] = (bf16)f2bf(o0 * rs * gla_norm_g[l * 512 + c0] * bf2f(SG[m * 512 + c0]));
            CAT[m * D + 512 + c0 + 64] = (bf16)f2bf(o1 * rs * gla_norm_g[l * 512 + c0 + 64] * bf2f(SG[m * 512 + c0 + 64])); }
        __syncthreads();
    }
}
__device__ __forceinline__ void final_phase(Frame& F) {
    PHASE_IDS();
    unsigned char* const ws_ = wsp(F);
    const float* const final_norm = ldp(F, P_FN);
    float* const SSQ = (float*)(ws_ + WS_SSQ);
    float* const out = outp(F);
    const int gw = blockIdx.x * NWAVES + wave, NGW = F.G * NWAVES;
    for (int m = gw; m < M; m += NGW) { const float rs = pg8::row_rs(SSQ, m); f32x4* xr = (f32x4*)(out + (size_t)m * D) + lane; const f32x4* gn = (const f32x4*)final_norm + lane;
#pragma unroll
        for (int j = 0; j < 4; ++j) xr[64 * j] = xr[64 * j] * gn[64 * j] * rs; }
}

struct Args { const float* in[23]; float* out; unsigned char* ws; };
#ifndef MK_STEP_LO
#define MK_STEP_LO 0
#define MK_STEP_HI 20
#endif
__device__ __forceinline__ void grid_barrier(const Frame& F) {
#if MK_CG_ALL
    cg::this_grid().sync();
#else
    XcdBarrier b; b.bar = (unsigned*)wsp(F) + CW_BAR; b.x = xb_xcc_id(); b.st = (volatile LAS unsigned*)(F.lds + MISC_OFF) + 8;
    xcd_barrier(b);
#endif
}
__global__ void __launch_bounds__(NWAVES * 64, 2) mk_fwd(Args args) {
    extern __shared__ __attribute__((aligned(16))) unsigned char lds[];
    Frame F;
    F.lds = (LAS unsigned char*)lds;
    F.G = gridDim.x; const int tid0 = threadIdx.x;
    for (int u = tid0; u < (LDS_BYTES - LDSCTL_OFF) / 4; u += NWAVES * 64) ((LAS unsigned*)(F.lds + LDSCTL_OFF))[u] = 0u;
    __syncthreads();
    if (tid0 < P_COUNT) { const unsigned long long p = tid0 < 23 ? (unsigned long long)args.in[tid0 < 23 ? tid0 : 0] : (tid0 == P_OUT ? (unsigned long long)args.out : (unsigned long long)args.ws);
        LAS unsigned* t = (LAS unsigned*)(F.lds + PT_OFF) + 2 * tid0; t[0] = (unsigned)p; t[1] = (unsigned)(p >> 32); }
    __syncthreads();
    (void)xcd_barrier_post((unsigned*)wsp(F) + CW_BAR, (volatile LAS unsigned*)(F.lds + MISC_OFF) + 8);
    prep_phase(F); convert_phase(F, 0);
    cg::this_grid().sync();
    for (int step = MK_STEP_LO; step < MK_STEP_HI; ++step) {
        const int l = step / 10, p = step - 10 * l;
        if (p == 0 || p == 7) {
            unsigned char* const ws_ = wsp(F);
            pg8::Gemm g{(const bf16*)(ws_ + WS_XB), (const bf16*)(ws_ + WS_W) + (p == 0 ? WE_GU1 : WE_GU2), M, 2 * FF, D}; pg8::StaticOrder S; S.init(M, 2 * FF, F.G, (int)blockIdx.x);
            pg8::EpiGU E{(bf16*)(ws_ + WS_HID), (const float*)(ws_ + WS_SSQ)};
            pg8::gemm_phase<pg8::EpiGU, pg8::StaticOrder, true, true>(F.lds, g, S, E);
        } else if (p == 1 || p == 6 || p == 8) {
            unsigned char* const ws_ = wsp(F); float* const out = outp(F);
            const bool first = (step == 1);
            pg8::Gemm g{(const bf16*)(ws_ + (p == 6 ? WS_CAT : WS_HID)), (const bf16*)(ws_ + WS_W) + (p == 1 ? WE_D1 : p == 6 ? WE_OUT : WE_D2), M, D, p == 6 ? D : FF}; pg8::StaticOrder S; S.init(M, D, F.G, (int)blockIdx.x);
            pg8::EpiRes E{first ? ldp(F, P_XP) : out, first ? ldp(F, P_XS) - (size_t)M_P * D : out, out, (bf16*)(ws_ + WS_XB), (float*)(ws_ + WS_SSQ), p == 6 ? 1.0f : 0.5f};
            pg8::gemm_phase<pg8::EpiRes, pg8::StaticOrder, true, true>(F.lds, g, S, E);
        } else if (p == 2) {
            unsigned char* const ws_ = wsp(F);
            pg8::Gemm g{(const bf16*)(ws_ + WS_XB), (const bf16*)(ws_ + WS_W) + WE_IN, M, NIN, D}; pg8::StaticOrder S; S.init(M, NIN, F.G, (int)blockIdx.x);
            pg8::EpiIn E{(bf16*)(ws_ + WS_Z), (bf16*)(ws_ + WS_Q), (bf16*)(ws_ + WS_K), (bf16*)(ws_ + WS_V), (bf16*)(ws_ + WS_SG), (float*)(ws_ + WS_LA), (const float*)(ws_ + WS_SSQ), ldp(F, P_GB) + l * 256};
            pg8::gemm_phase<pg8::EpiIn, pg8::StaticOrder, true, true>(F.lds, g, S, E);
        } else if (p == 3) { conv_phase(F, l); gla1_phase(F, l); }
        else if (p == 4) scan_phase(F, l);
        else if (p == 5) gla2_phase(F, l);
        else { if (l + 1 < NL) convert_phase(F, l + 1); else continue; }
        grid_barrier(F);
    }
    final_phase(F);
}

extern "C" void kernel_launch(void* const* d_in, const int* in_sizes, int n_in, void* d_out, int out_size, void* d_ws, size_t ws_size, hipStream_t stream) {
    static int grid = 0;
    if (grid == 0) {
        if (n_in != 23 || in_sizes[0] != M_P * D || in_sizes[1] != M_S * D || (size_t)out_size != OUT_END || ws_size < WS_END) {
            fprintf(stderr, "kernel_launch: unexpected shapes (n_in %d, in0 %d, in1 %d, out %d, ws %zu); nothing launched\n", n_in, n_in > 0 ? in_sizes[0] : -1, n_in > 1 ? in_sizes[1] : -1, out_size, ws_size); grid = -1; return; }
        int dev = 0, cus = 0, per_cu = 0;
        if (hipGetDevice(&dev) != hipSuccess || hipDeviceGetAttribute(&cus, hipDeviceAttributeMultiprocessorCount, dev) != hipSuccess) { grid = -1; return; }
        if (hipFuncSetAttribute((const void*)mk_fwd, hipFuncAttributeMaxDynamicSharedMemorySize, LDS_BYTES) != hipSuccess) { fprintf(stderr, "kernel_launch: hipFuncSetAttribute failed\n"); grid = -1; return; }
        if (hipOccupancyMaxActiveBlocksPerMultiprocessor(&per_cu, (const void*)mk_fwd, NWAVES * 64, LDS_BYTES) != hipSuccess || per_cu < 1) { fprintf(stderr, "kernel_launch: occupancy query failed (%d)\n", per_cu); (void)hipGetLastError(); grid = -1; return; }
        grid = cus * 1;
    }
    if (grid < 0) return;
    if (hipMemsetAsync((char*)d_ws + WS_CTL, 0, CTL_ZERO_BYTES, stream) != hipSuccess) { fprintf(stderr, "kernel_launch: hipMemsetAsync failed\n"); return; }
    Args a{};
    for (int i = 0; i < 23; ++i) a.in[i] = (const float*)d_in[i];
    a.out = (float*)d_out; a.ws = (unsigned char*)d_ws;
    void* params[] = {&a};
    const hipError_t e = hipLaunchCooperativeKernel((const void*)mk_fwd, dim3(grid), dim3(NWAVES * 64), params, LDS_BYTES, stream);
    if (e != hipSuccess) fprintf(stderr, "kernel_launch: cooperative launch failed: %s (grid %d)\n", hipGetErrorString(e), grid);
}
```

```cpp
#include <hip/hip_runtime.h>
#include <hip/hip_cooperative_groups.h>
#include <cstdio>
#include <cstdint>
namespace cg = cooperative_groups;
#ifndef MK_CG_ALL
#define MK_CG_ALL 0
#endif
namespace pg8 {
#define PG8_LAS __attribute__((address_space(3)))
typedef unsigned short bf16_t;
typedef short bf16x8 __attribute__((ext_vector_type(8)));
typedef float f32x4 __attribute__((ext_vector_type(4)));
typedef unsigned u32x4 __attribute__((ext_vector_type(4)));
constexpr int BM = 256, BK = 64, HALF = 128, HTB = HALF * BK * 2  , STAGE_BYTES = 8 * HTB, NXCD = 8, WGM = 8;

__host__ __device__ __forceinline__ int lds_byte(int r, int c) { const int st = (r >> 4) * 2 + (c >> 5), rr = r & 15, cc = c & 31, ob = rr * 64 + cc * 2; return st * 1024 + (ob ^ (((ob >> 9) & 1) << 5)); }
__host__ __device__ __forceinline__ void stage_rc(int b, int& R, int& C) { const int st = b / 1024, sb = b % 1024, swz = sb ^ (((sb >> 9) & 1) << 5); R = (st >> 1) * 16 + swz / 64; C = (st & 1) * 32 + (swz % 64) / 2; }
__host__ __device__ __forceinline__ int perm32(int rho) { const int n = rho >> 4, i = rho & 15; return 8 * (i >> 2) + 4 * n + (i & 3); }

struct Unit { int pm, pn; };
struct Gemm { const bf16_t* A; const bf16_t* Bt; int M, N, K; };

struct StaticOrder {
    int nM, nN, nwg, G, c;
    __host__ __device__ void init(int M, int N, int G_, int c_) { nM = M / BM; nN = N / BM; nwg = nM * nN; G = G_; c = c_; }
    __host__ __device__ bool next(int i, Unit& u) const {
        const long L = (long)i * G + c; if (L >= nwg) return false;
        int wgid = (int)L; { const int q = nwg / NXCD, r = nwg % NXCD, xcd = wgid % NXCD, off = wgid / NXCD; wgid = (xcd < r ? xcd * (q + 1) : r * (q + 1) + (xcd - r) * q) + off; }
        const int nig = WGM * nN, gid = wgid / nig, fm = gid * WGM, gsz = (nM - fm) < WGM ? (nM - fm) : WGM;
        u.pm = fm + ((wgid % nig) % gsz); u.pn = (wgid % nig) / gsz; return true;
    }
    __device__ __forceinline__ void a_ready(const Unit&) const {}
    __device__ __forceinline__ void done(const Unit&) const {}
};


__device__ __forceinline__ unsigned cvt_pk_bf16(float lo, float hi) { unsigned r; asm volatile("v_cvt_pk_bf16_f32 %0, %1, %2" : "=v"(r) : "v"(lo), "v"(hi)); return r; }
constexpr int DM = 1024, DFF = 2816;
__device__ __forceinline__ float row_rs(const float* ssq, int r) {
    const f32x4* p = (const f32x4*)(ssq + (size_t)r * 16);
    const f32x4 a = p[0], b = p[1], c = p[2], d = p[3];
    const f32x4 s = (a + b) + (c + d);
    return rsqrtf(((s[0] + s[1]) + (s[2] + s[3])) * (1.0f / 1024.0f) + 1e-6f);
}
__device__ __forceinline__ float sigm(float x) { return __builtin_amdgcn_rcpf(1.0f + __expf(-x)); }
__device__ __forceinline__ float silu_f(float x) { return x * sigm(x); }

struct EpiGU {
    static constexpr bool PERM = true, AFTER_DRAIN = false;
    bf16_t* H; const float* ssq;
    __device__ __forceinline__ void operator()(const f32x4 (&acc)[2][2][4][2], const Unit& u, int wr, int wc, int fr, int fq) const {
        const int row0 = u.pm * BM + wr * 64 + fr, col0 = u.pn * 128 + wc * 32 + 8 * fq;
#pragma unroll
        for (int ai = 0; ai < 2; ++ai)
#pragma unroll
            for (int m = 0; m < 4; ++m) {
                const int r = row0 + ai * HALF + m * 16; const float rs = row_rs(ssq, r);
                const f32x4 g0 = acc[ai][0][m][0] * rs, g1 = acc[ai][0][m][1] * rs, u0 = acc[ai][1][m][0] * rs, u1 = acc[ai][1][m][1] * rs;
                float h[8];
#pragma unroll
                for (int j = 0; j < 4; ++j) { h[j] = silu_f(g0[j]) * u0[j]; h[4 + j] = silu_f(g1[j]) * u1[j]; }
                u32x4 w; w.x = cvt_pk_bf16(h[0], h[1]); w.y = cvt_pk_bf16(h[2], h[3]); w.z = cvt_pk_bf16(h[4], h[5]); w.w = cvt_pk_bf16(h[6], h[7]);
                *(u32x4*)(H + (size_t)r * DFF + col0) = w;
            }
    }
};
struct EpiRes {
    static constexpr bool PERM = false, AFTER_DRAIN = false;
    const float* xin_p; const float* xin_s; float* xout; bf16_t* xb; float* ssq; float scale;
    __device__ __forceinline__ void operator()(const f32x4 (&acc)[2][2][4][2], const Unit& u, int wr, int wc, int fr, int fq) const {
        typedef unsigned u32x2 __attribute__((ext_vector_type(2)));
        const int row0 = u.pm * BM + wr * 64 + fr, col0 = u.pn * BM + wc * 32 + 4 * fq;
        const float* xin = (u.pm < 64) ? xin_p : xin_s;
#pragma unroll
        for (int ai = 0; ai < 2; ++ai)
#pragma unroll
            for (int m = 0; m < 4; ++m) {
                const int r = row0 + ai * HALF + m * 16; const size_t off = (size_t)r * DM + col0; float s = 0.f;
#pragma unroll
                for (int bj = 0; bj < 2; ++bj)
#pragma unroll
                    for (int n = 0; n < 2; ++n) {
                        const int c = bj * HALF + n * 16;
                        const f32x4 xo = *(const f32x4*)(xin + off + c);
                        const f32x4 xn = xo + acc[ai][bj][m][n] * scale;
                        *(f32x4*)(xout + off + c) = xn;
                        u32x2 w; w.x = cvt_pk_bf16(xn[0], xn[1]); w.y = cvt_pk_bf16(xn[2], xn[3]);
                        *(u32x2*)(xb + off + c) = w;
                        s += (xn[0] * xn[0] + xn[1] * xn[1]) + (xn[2] * xn[2] + xn[3] * xn[3]);
                    }
                s += __shfl_xor(s, 16); s += __shfl_xor(s, 32);
                if (fq == 0) ssq[(size_t)r * 16 + u.pn * 4 + wc] = s;
                if (m & 1) asm volatile("" ::: "memory");
            }
    }
};
struct EpiIn {
    static constexpr bool PERM = true, AFTER_DRAIN = false;
    bf16_t *Z, *Q, *K, *V, *SG; float* LA; const float* ssq; const float* gate_b;
    __device__ __forceinline__ void operator()(const f32x4 (&acc)[2][2][4][2], const Unit& u, int wr, int wc, int fr, int fq) const {
        const int row0 = u.pm * BM + wr * 64 + fr, cl0 = wc * 32 + 8 * fq, pn = u.pn;
        if (pn < 4) {
#pragma unroll
            for (int ai = 0; ai < 2; ++ai)
#pragma unroll
                for (int m = 0; m < 4; ++m) {
                    const int r = row0 + ai * HALF + m * 16; const float rs = row_rs(ssq, r);
                    const f32x4 a0 = acc[ai][0][m][0] * rs, a1 = acc[ai][0][m][1] * rs, b0 = acc[ai][1][m][0] * rs, b1 = acc[ai][1][m][1] * rs;
                    float h[8];
#pragma unroll
                    for (int j = 0; j < 4; ++j) { h[j] = a0[j] * sigm(b0[j]); h[4 + j] = a1[j] * sigm(b1[j]); }
                    u32x4 w; w.x = cvt_pk_bf16(h[0], h[1]); w.y = cvt_pk_bf16(h[2], h[3]); w.z = cvt_pk_bf16(h[4], h[5]); w.w = cvt_pk_bf16(h[6], h[7]);
                    *(u32x4*)(Z + (size_t)r * 512 + pn * 128 + cl0) = w;
                }
        } else if (pn == 10) {
            f32x4 gb[2][2];
#pragma unroll
            for (int bj = 0; bj < 2; ++bj)
#pragma unroll
                for (int n = 0; n < 2; ++n) gb[bj][n] = *(const f32x4*)(gate_b + bj * HALF + cl0 + 4 * n);
#pragma unroll
            for (int ai = 0; ai < 2; ++ai)
#pragma unroll
                for (int m = 0; m < 4; ++m) {
                    const int r = row0 + ai * HALF + m * 16; const float rs = row_rs(ssq, r);
#pragma unroll
                    for (int bj = 0; bj < 2; ++bj)
#pragma unroll
                        for (int n = 0; n < 2; ++n) {
                            const f32x4 x = acc[ai][bj][m][n] * rs + gb[bj][n]; f32x4 o;
#pragma unroll
                            for (int j = 0; j < 4; ++j) o[j] = (fminf(x[j], 0.f) - __logf(1.0f + __expf(-fabsf(x[j])))) * 0.0625f;
                            *(f32x4*)(LA + (size_t)r * 256 + bj * HALF + cl0 + 4 * n) = o;
                        }
                }
        } else {
            bf16_t* dst; int ld, cb; float sc = 1.f; const bool act = (pn >= 8);
            if (pn == 4) { dst = Q; ld = 256; cb = 0; sc = 0.125f; } else if (pn == 5) { dst = K; ld = 256; cb = 0; }
            else if (pn < 8) { dst = V; ld = 512; cb = (pn - 6) * 256; } else { dst = SG; ld = 512; cb = (pn - 8) * 256; }
#pragma unroll
            for (int ai = 0; ai < 2; ++ai)
#pragma unroll
                for (int m = 0; m < 4; ++m) {
                    const int r = row0 + ai * HALF + m * 16; const float rs = row_rs(ssq, r) * sc;
#pragma unroll
                    for (int bj = 0; bj < 2; ++bj) {
                        f32x4 v0 = acc[ai][bj][m][0] * rs, v1 = acc[ai][bj][m][1] * rs;
                        if (act) {
#pragma unroll
                            for (int j = 0; j < 4; ++j) { v0[j] = silu_f(v0[j]); v1[j] = silu_f(v1[j]); }
                        }
                        u32x4 w; w.x = cvt_pk_bf16(v0[0], v0[1]); w.y = cvt_pk_bf16(v0[2], v0[3]); w.z = cvt_pk_bf16(v1[0], v1[1]); w.w = cvt_pk_bf16(v1[2], v1[3]);
                        *(u32x4*)(dst + (size_t)r * ld + cb + bj * HALF + cl0) = w;
                    }
                }
        }
    }
};

template <class Epi, class Sched, bool ALIGN_EPI = false, bool SP2 = false>
__device__ __forceinline__ void gemm_phase(PG8_LAS unsigned char* lds, const Gemm g, const Sched& S, const Epi& E, const int wave_id) {
    int lane0_; asm volatile("v_mbcnt_lo_u32_b32 %0, -1, 0\n\tv_mbcnt_hi_u32_b32 %0, -1, %0" : "=v"(lane0_)); const int tid_ = wave_id * 64 + lane0_;
    const int tid = tid_, wid = wave_id, lane = tid & 63, wr = wid >> 2, wc = wid & 3, fr = lane & 15, fq = lane >> 4;
    const int K = g.K, nt = K / BK;
    unsigned voffA[2], voffB[2];
#pragma unroll
    for (int i = 0; i < 2; ++i) { int R, C; stage_rc(tid * 16 + i * 8192, R, C); const int Rb = Epi::PERM ? ((R & ~31) + perm32(R & 31)) : R;
        voffA[i] = (unsigned)(R * K + C) * 2u; voffB[i] = (unsigned)(Rb * K + C) * 2u; }
    const size_t kstep = (size_t)(BK * 2);
    const size_t hstep = (size_t)HALF * K * 2;
    const size_t tstep = 2 * hstep;
    const unsigned ldsw = (unsigned)wid * 1024u;
    const int aoff = lds_byte(wr * 64 + fr, fq * 8), boff = lds_byte(wc * 32 + fr, fq * 8);
#define PG8_SA(b, h) (((b) * 2 + (h)) * HTB)
#define PG8_SB(b, h) ((4 + (b) * 2 + (h)) * HTB)
#define PG8_STAGE(bufoff, gbase, voff) do { _Pragma("unroll") for (int _i = 0; _i < 2; ++_i) \
        __builtin_amdgcn_global_load_lds((const unsigned*)((const char*)(gbase) + (voff)[_i]), (PG8_LAS unsigned*)(lds + (bufoff) + ldsw + _i * 8192), 16, 0, 0); } while (0)
#define PG8_LDA(dst, b, h) do { _Pragma("unroll") for (int m = 0; m < 4; ++m) _Pragma("unroll") for (int k = 0; k < 2; ++k) dst[m][k] = *(const PG8_LAS bf16x8*)(lds + PG8_SA(b, h) + aoff + m * 2048 + k * 1024); } while (0)
#define PG8_LDB(dst, b, h) do { _Pragma("unroll") for (int n = 0; n < 2; ++n) _Pragma("unroll") for (int k = 0; k < 2; ++k) dst[n][k] = *(const PG8_LAS bf16x8*)(lds + PG8_SB(b, h) + boff + n * 2048 + k * 1024); } while (0)
#define PG8_MMA(ai, bj, At, Bt) do { __builtin_amdgcn_s_setprio(1); _Pragma("unroll") for (int m = 0; m < 4; ++m) _Pragma("unroll") for (int n = 0; n < 2; ++n) _Pragma("unroll") for (int k = 0; k < 2; ++k) \
        acc[ai][bj][m][n] = __builtin_amdgcn_mfma_f32_16x16x32_bf16(Bt[n][k], At[m][k], acc[ai][bj][m][n], 0, 0, 0); __builtin_amdgcn_s_setprio(0); } while (0)
#define PG8_WAIT_V(n) asm volatile("s_waitcnt vmcnt(" #n ")" ::: "memory")
#define PG8_WAIT_L(n) asm volatile("s_waitcnt lgkmcnt(" #n ")" ::: "memory")
#define PG8_BAR __builtin_amdgcn_s_barrier()
#define PG8_SCHED __builtin_amdgcn_sched_barrier(0)
    Unit cur, nxt; int ui = 0;
    if (!S.next(0, cur)) return;
    f32x4 acc[2][2][4][2];
#pragma unroll
    for (int a = 0; a < 2; ++a)
#pragma unroll
        for (int b = 0; b < 2; ++b)
#pragma unroll
            for (int m = 0; m < 4; ++m)
#pragma unroll
                for (int n = 0; n < 2; ++n) acc[a][b][m][n] = (f32x4){0.f, 0.f, 0.f, 0.f};
    bf16x8 At[4][2], B0[2][2], B1[2][2];
    const char* cA = (const char*)g.A + (size_t)cur.pm * tstep; const char* cB = (const char*)g.Bt + (size_t)cur.pn * tstep;
    S.a_ready(cur);
    if constexpr (SP2) {
        PG8_STAGE(PG8_SB(0, 0), cB, voffB); PG8_STAGE(PG8_SB(0, 1), cB + hstep, voffB); PG8_STAGE(PG8_SA(0, 0), cA, voffA); PG8_STAGE(PG8_SA(0, 1), cA + hstep, voffA);
        if (wr == 1) PG8_BAR;
        PG8_WAIT_V(2); PG8_BAR;
        PG8_STAGE(PG8_SB(1, 0), cB + kstep, voffB); PG8_STAGE(PG8_SA(1, 0), cA + kstep, voffA); PG8_STAGE(PG8_SB(1, 1), cB + hstep + kstep, voffB);
        PG8_WAIT_V(6); PG8_BAR;
    } else {
        PG8_STAGE(PG8_SB(0, 0), cB, voffB); PG8_STAGE(PG8_SA(0, 0), cA, voffA); PG8_STAGE(PG8_SB(0, 1), cB + hstep, voffB); PG8_STAGE(PG8_SA(0, 1), cA + hstep, voffA);
        if (wr == 1) PG8_BAR;
        PG8_WAIT_V(4); PG8_BAR;
        PG8_STAGE(PG8_SB(1, 0), cB + kstep, voffB); PG8_STAGE(PG8_SA(1, 0), cA + kstep, voffA); PG8_STAGE(PG8_SB(1, 1), cB + hstep + kstep, voffB);
        PG8_WAIT_V(6); PG8_BAR;
    }
    for (;;) {
        const bool has_next = S.next(ui + 1, nxt);
        const char* nA = has_next ? (const char*)g.A + (size_t)nxt.pm * tstep : cA; const char* nB = has_next ? (const char*)g.Bt + (size_t)nxt.pn * tstep : cB;
        for (int t = 0; t < nt; t += 2) {
            const bool last = (t == nt - 2);
            const char* a1 = cA + (size_t)(t + 1) * kstep;
            const char* a2 = last ? nA : cA + (size_t)(t + 2) * kstep; const char* b2 = last ? nB : cB + (size_t)(t + 2) * kstep;
            const char* a3 = a2 + kstep; const char* b3 = b2 + kstep;
            if (last && has_next) S.a_ready(nxt);
            if constexpr (SP2) {
            PG8_LDB(B0, 0, 0); PG8_LDB(B1, 0, 1); PG8_SCHED; PG8_LDA(At, 0, 0); PG8_STAGE(PG8_SA(1, 1), a1 + hstep, voffA);
            PG8_WAIT_V(8); PG8_WAIT_L(0); PG8_BAR; PG8_MMA(0, 0, At, B0); PG8_MMA(0, 1, At, B1); PG8_BAR; PG8_SCHED;
            PG8_LDA(At, 0, 1); PG8_STAGE(PG8_SB(0, 0), b2, voffB); PG8_STAGE(PG8_SB(0, 1), b2 + hstep, voffB); PG8_STAGE(PG8_SA(0, 0), a2, voffA);
            PG8_WAIT_V(8); PG8_WAIT_L(0); PG8_BAR; PG8_MMA(1, 0, At, B0); PG8_MMA(1, 1, At, B1); PG8_BAR; PG8_SCHED;
            PG8_LDB(B0, 1, 0); PG8_LDB(B1, 1, 1); PG8_SCHED; PG8_LDA(At, 1, 0); PG8_STAGE(PG8_SA(0, 1), a2 + hstep, voffA);
            PG8_WAIT_V(8); PG8_WAIT_L(0); PG8_BAR; PG8_MMA(0, 0, At, B0); PG8_MMA(0, 1, At, B1); PG8_BAR; PG8_SCHED;
            PG8_LDA(At, 1, 1); PG8_STAGE(PG8_SB(1, 0), b3, voffB); PG8_STAGE(PG8_SB(1, 1), b3 + hstep, voffB); PG8_STAGE(PG8_SA(1, 0), a3, voffA);
            PG8_WAIT_V(8); PG8_WAIT_L(0); PG8_BAR; PG8_MMA(1, 0, At, B0); PG8_MMA(1, 1, At, B1); PG8_BAR; PG8_SCHED;
            } else {
            PG8_LDB(B0, 0, 0); PG8_SCHED; PG8_LDA(At, 0, 0); PG8_STAGE(PG8_SA(1, 1), a1 + hstep, voffA);
            PG8_WAIT_L(8); PG8_BAR; PG8_WAIT_L(0); PG8_MMA(0, 0, At, B0); PG8_BAR; PG8_SCHED;
            PG8_LDB(B1, 0, 1); PG8_STAGE(PG8_SB(0, 0), b2, voffB);
            PG8_BAR; PG8_WAIT_L(0); PG8_MMA(0, 1, At, B1); PG8_BAR;
            PG8_LDA(At, 0, 1); PG8_STAGE(PG8_SA(0, 0), a2, voffA);
            PG8_BAR; PG8_WAIT_L(0); PG8_MMA(1, 0, At, B0); PG8_BAR; PG8_SCHED;
            PG8_STAGE(PG8_SB(0, 1), b2 + hstep, voffB);
            PG8_WAIT_V(6); PG8_BAR; PG8_MMA(1, 1, At, B1); PG8_BAR;
            PG8_LDB(B0, 1, 0); PG8_SCHED; PG8_LDA(At, 1, 0); PG8_STAGE(PG8_SA(0, 1), a2 + hstep, voffA);
            PG8_WAIT_L(8); PG8_BAR; PG8_WAIT_L(0); PG8_MMA(0, 0, At, B0); PG8_BAR; PG8_SCHED;
            PG8_LDB(B1, 1, 1); PG8_STAGE(PG8_SB(1, 0), b3, voffB);
            PG8_BAR; PG8_WAIT_L(0); PG8_MMA(0, 1, At, B1); PG8_BAR;
            PG8_LDA(At, 1, 1); PG8_STAGE(PG8_SA(1, 0), a3, voffA);
            PG8_BAR; PG8_WAIT_L(0); PG8_MMA(1, 0, At, B0); PG8_BAR; PG8_SCHED;
            PG8_STAGE(PG8_SB(1, 1), b3 + hstep, voffB);
            PG8_WAIT_V(6); PG8_BAR; PG8_MMA(1, 1, At, B1); PG8_BAR;
            }
        }
        if constexpr (ALIGN_EPI) { if (wr == 0) PG8_BAR; }
        if constexpr (!Epi::AFTER_DRAIN) { E(acc, cur, wr, wc, fr, fq); S.done(cur); }
        if (!has_next) break;
#pragma unroll
        for (int a = 0; a < 2; ++a)
#pragma unroll
            for (int b = 0; b < 2; ++b)
#pragma unroll
                for (int m = 0; m < 4; ++m)
#pragma unroll
                    for (int n = 0; n < 2; ++n) acc[a][b][m][n] = (f32x4){0.f, 0.f, 0.f, 0.f};
        cur = nxt; cA = nA; cB = nB; ++ui;
        if constexpr (ALIGN_EPI) { if (wr == 1) PG8_BAR; }
    }
    PG8_WAIT_V(0);
    if constexpr (!ALIGN_EPI) { if (wr == 0) PG8_BAR; }
    PG8_BAR;
    if constexpr (Epi::AFTER_DRAIN) { E.fused(acc, cur, wr, wc, fr, fq, lds, wid, lane); S.done(cur); }
#undef PG8_SA
#undef PG8_SB
#undef PG8_STAGE
#undef PG8_LDA
#undef PG8_LDB
#undef PG8_MMA
#undef PG8_WAIT_V
#undef PG8_WAIT_L
#undef PG8_BAR
#undef PG8_SCHED
}
}
#define GAS __attribute__((address_space(1)))
#define LAS __attribute__((address_space(3)))
typedef unsigned short bf16;
typedef unsigned v4u __attribute__((ext_vector_type(4)));
typedef float f32x4 __attribute__((ext_vector_type(4)));
typedef short bf16x8 __attribute__((ext_vector_type(8)));
typedef GAS unsigned gu32;
typedef GAS unsigned long long gu64;
#define RLX_AGENT __ATOMIC_RELAXED, __HIP_MEMORY_SCOPE_AGENT
#define LDS_WAIT() asm volatile("s_waitcnt lgkmcnt(0)" ::: "memory")
#define VM_WAIT() asm volatile("s_waitcnt vmcnt(0)" ::: "memory")
__device__ __forceinline__ unsigned long long rt() { return __builtin_amdgcn_s_memrealtime(); }
__device__ __forceinline__ unsigned f2bf(float f) { unsigned u = __builtin_bit_cast(unsigned, f); return (u + 0x7fffu + ((u >> 16) & 1u)) >> 16; }
__device__ __forceinline__ unsigned pk2(float lo, float hi) { return f2bf(lo) | (f2bf(hi) << 16); }

#define XB_TMO      128
#define XB_XCNT(j)  (256  + 64 * (j))
#define XB_XSUB(j)  (1280 + 64 * (j))
#define XB_XGEN(j)  (2304 + 64 * (j))
#define XB_TOP      3328
#define XB_TOPGEN   3392
#define XCD_BAR_WORDS 3456
#define XB_SPIN_CAP (1u << 18)

__device__ __forceinline__ unsigned xb_ld(unsigned* p)              { return __hip_atomic_load(p, __ATOMIC_RELAXED, __HIP_MEMORY_SCOPE_AGENT); }
__device__ __forceinline__ unsigned xb_add(unsigned* p, unsigned v) { return __hip_atomic_fetch_add(p, v, __ATOMIC_RELAXED, __HIP_MEMORY_SCOPE_AGENT); }
__device__ __forceinline__ unsigned xb_xcc_id() { return (unsigned)__builtin_amdgcn_s_getreg((3 << 11) | 20) & 0xFu; }
#define XB_SPIN(cond, bar) do { unsigned _sp = 0; while (cond) { __builtin_amdgcn_s_sleep(1); \
    if ((++_sp & 255u) == 0u) { if (xb_ld(&(bar)[XB_TMO])) break; if (_sp > XB_SPIN_CAP) { atomicAdd(&(bar)[XB_TMO], 1u); break; } } } } while (0)

struct XcdBarrier {
    unsigned* bar; unsigned x;
    volatile LAS unsigned* st;
};

__device__ __forceinline__ bool xb_thread0(int wave) { int l_; asm volatile("v_mbcnt_lo_u32_b32 %0, -1, 0\n\tv_mbcnt_hi_u32_b32 %0, -1, %0" : "=v"(l_)); return wave == 0 && l_ == 0; }
__device__ __forceinline__ XcdBarrier xcd_barrier_post(unsigned* bar, volatile LAS unsigned* st, int wave) {
    XcdBarrier b; b.bar = bar; b.x = xb_xcc_id(); b.st = st;
    if (xb_thread0(wave)) (void)xb_add(&bar[XB_XCNT(b.x)], 1u);
    return b;
}
__device__ __forceinline__ void xcd_barrier_complete(unsigned* bar, unsigned x, unsigned& nloc, unsigned& nx) {
    const unsigned G = gridDim.x * gridDim.y * gridDim.z;
    unsigned sum, cnt, mine, sp = 0u;
    for (;;) {
        sum = 0u; cnt = 0u; mine = 0u;
#pragma unroll
        for (unsigned j = 0; j < 16; ++j) { const unsigned c = xb_ld(&bar[XB_XCNT(j)]); sum += c; cnt += (c > 0u) ? 1u : 0u; mine = (j == x) ? c : mine; }
        if (sum == G) break;
        __builtin_amdgcn_s_sleep(1);
        if ((++sp & 255u) == 0u) { if (xb_ld(&bar[XB_TMO])) break; if (sp > XB_SPIN_CAP) { atomicAdd(&bar[XB_TMO], 1u); break; } }
    }
    nloc = mine > 0u ? mine : 1u; nx = cnt > 0u ? cnt : 1u;
}

__device__ __forceinline__ void xcd_barrier(const XcdBarrier& b, int wave) {
    asm volatile("s_waitcnt vmcnt(0)" ::: "memory");
    __syncthreads();
    if (xb_thread0(wave)) {
        unsigned* bar = b.bar;
        __builtin_amdgcn_s_waitcnt(0);
        unsigned nloc = b.st[0], nx = b.st[1];
        if (nloc == 0u) { xcd_barrier_complete(bar, b.x, nloc, nx); b.st[0] = nloc; b.st[1] = nx; }
        const unsigned old = xb_add(&bar[XB_XSUB(b.x)], 1u);
        const unsigned gen = old / nloc;
        if (old + 1u == (gen + 1u) * nloc) {
            __builtin_amdgcn_fence(__ATOMIC_RELEASE, "agent");
            asm volatile("s_waitcnt vmcnt(0)" ::: "memory");
            const unsigned og = xb_add(&bar[XB_TOP], 1u);
            const unsigned tg = og / nx;
            if (og + 1u == (tg + 1u) * nx) xb_add(&bar[XB_TOPGEN], 1u);
            else XB_SPIN(xb_ld(&bar[XB_TOPGEN]) == tg, bar);
            __builtin_amdgcn_fence(__ATOMIC_ACQUIRE, "agent");
            xb_add(&bar[XB_XGEN(b.x)], 1u);
            asm volatile("s_waitcnt vmcnt(0)" ::: "memory");
        } else {
            XB_SPIN(xb_ld(&bar[XB_XGEN(b.x)]) == gen, bar);
            __builtin_amdgcn_fence(__ATOMIC_ACQUIRE, "agent");
            asm volatile("s_waitcnt vmcnt(0)" ::: "memory");
        }
    }
    __syncthreads();
}

constexpr int NWAVES = 8;
constexpr int D = 1024, FF = 2816, NL = 2;
constexpr int M_P = 4 * 4096, M_S = 32 * 64, M = M_P + M_S;
constexpr int NCH = M / 64, NCH_P = M_P / 64;
constexpr int IN_W = 2576, NIN = 2816;
constexpr size_t OFF_Y = 0, OFF_CONV_P = (size_t)M * D, OFF_GLA_P = OFF_CONV_P + 2 * 4 * 30 * 512, OFF_CONV_S = OFF_GLA_P + 2 * 4 * 4 * 64 * 128,
                 OFF_GLA_S = OFF_CONV_S + 2 * 32 * 30 * 512, OUT_END = OFF_GLA_S + 2 * 32 * 4 * 64 * 128;
constexpr size_t MiB = 1u << 20;
constexpr size_t WS_CTL = 0, CTL_ZERO_BYTES = 65536;
constexpr size_t WS_SSQ = 1 * MiB;
constexpr size_t WS_DEC = 3 * MiB;
constexpr size_t WS_W = 4 * MiB;
constexpr size_t WE_GU1 = 0, WE_D1 = WE_GU1 + (size_t)2 * FF * D, WE_IN = WE_D1 + (size_t)D * FF, WE_OUT = WE_IN + (size_t)NIN * D, WE_GU2 = WE_OUT + (size_t)D * D,
                 WE_D2 = WE_GU2 + (size_t)2 * FF * D, WE_END = WE_D2 + (size_t)D * FF;
constexpr size_t WS_XB = 45 * MiB;
constexpr size_t WS_R = 81 * MiB;
constexpr size_t WS_HID = WS_R;
constexpr size_t WS_Z = WS_R, WS_Q = WS_Z + 18 * MiB, WS_K = WS_Q + 9 * MiB, WS_V = WS_K + 9 * MiB, WS_SG = WS_V + 18 * MiB, WS_LA = WS_SG + 18 * MiB;
constexpr size_t WS_CAT = WS_R + 90 * MiB;
constexpr size_t WS_ST = WS_CAT + 36 * MiB;
constexpr size_t WS_END = WS_ST + 32 * MiB;
static_assert(WS_W + WE_END * 2 <= WS_XB && WS_XB + (size_t)M * D * 2 <= WS_R && WS_HID + (size_t)M * FF * 2 <= WS_END && WS_LA + (size_t)M * 256 * 4 <= WS_CAT, "d_ws map");
constexpr int CW_BAR = 4096;
constexpr int RING_BYTES = 131072, LDSCTL_OFF = RING_BYTES, MISC_OFF = LDSCTL_OFF + 320, LDS_BYTES = 147456;

constexpr int PT_OFF = MISC_OFF + 128;
enum { P_XP = 0, P_XS, P_CC, P_ST0, P_F1N, P_F1G, P_F1U, P_F1D, P_MN, P_WIN, P_DWW, P_DWB, P_LNG, P_LNB, P_GW2, P_GB, P_GNG, P_WOUT, P_F2N, P_F2G, P_F2U, P_F2D, P_FN, P_OUT, P_WS, P_COUNT };
static_assert(PT_OFF + P_COUNT * 8 <= LDS_BYTES, "LDS map");
struct Frame { LAS unsigned char* lds; int G, wave; };
#define PHASE_IDS() int lane_; asm volatile("v_mbcnt_lo_u32_b32 %0, -1, 0\n\tv_mbcnt_hi_u32_b32 %0, -1, %0" : "=v"(lane_)); const int lane = lane_, wave = F.wave, tid = wave * 64 + lane; (void)tid
__device__ __forceinline__ unsigned long long ldp_raw(const Frame& F, int i) {
    const volatile LAS unsigned* t = (const volatile LAS unsigned*)(F.lds + PT_OFF) + 2 * i;
    const unsigned lo = __builtin_amdgcn_readfirstlane(t[0]), hi = __builtin_amdgcn_readfirstlane(t[1]);
    return ((unsigned long long)hi << 32) | lo;
}
__device__ __forceinline__ void* as_global(unsigned long long a) {
#if defined(__HIP_DEVICE_COMPILE__)
    return (void*)(GAS void*)a;
#else
    return (void*)a;
#endif
}
__device__ __forceinline__ const float* ldp(const Frame& F, int i) { return (const float*)as_global(ldp_raw(F, i)); }
__device__ __forceinline__ float* outp(const Frame& F) { return (float*)as_global(ldp_raw(F, P_OUT)); }
__device__ __forceinline__ unsigned char* wsp(const Frame& F) { return (unsigned char*)as_global(ldp_raw(F, P_WS)); }
__device__ __forceinline__ float wave_sum(float v) {
#pragma unroll
    for (int o = 1; o < 64; o <<= 1) v += __shfl_xor(v, o);
    return v;
}
__device__ __forceinline__ float bf2f(bf16 h) { return __builtin_bit_cast(float, (unsigned)h << 16); }

__device__ __forceinline__ void tr_store(LAS float* scr, bf16* WT, int ldk, int drow0, int k0, int lane) {
    LDS_WAIT(); asm volatile("" ::: "memory");
    const int c = lane & 7;
#pragma unroll
    for (int j = 0; j < 4; ++j) { const int n = (lane >> 3) + 8 * j; const LAS float* s = scr + (8 * c) * 33 + n;
        v4u o; o.x = pk2(s[0 * 33], s[1 * 33]); o.y = pk2(s[2 * 33], s[3 * 33]); o.z = pk2(s[4 * 33], s[5 * 33]); o.w = pk2(s[6 * 33], s[7 * 33]);
        *(GAS v4u*)(WT + (size_t)(drow0 + n) * ldk + k0 + 8 * c) = o; }
    LDS_WAIT(); asm volatile("" ::: "memory");
}
__device__ __forceinline__ void tr_item(const float* W, int ldn, int k0, int n0, const float* gain, bf16* WT, int ldk, int drow0, LAS float* scr, int lane) {
#pragma unroll
    for (int i = 0; i < 32; ++i) { const int kk = 2 * i + (lane >> 5); float v = W[(size_t)(k0 + kk) * ldn + n0 + (lane & 31)]; if (gain) v *= gain[k0 + kk]; scr[kk * 33 + (lane & 31)] = v; }
    tr_store(scr, WT, ldk, drow0, k0, lane);
}
__device__ __forceinline__ void la_item(const float* Win, const float* w2, int k0, int n0, const float* gain, bf16* WT, int drow0, LAS float* scr, int lane) {
    float wc[16];
#pragma unroll
    for (int r = 0; r < 16; ++r) wc[r] = w2[r * 256 + n0 + (lane & 31)];
#pragma unroll 4
    for (int i = 0; i < 32; ++i) { const int kk = 2 * i + (lane >> 5); const float* wr_ = Win + (size_t)(k0 + kk) * IN_W + 2560; float a = 0.f;
#pragma unroll
        for (int r = 0; r < 16; ++r) a += wr_[r] * wc[r];
        scr[kk * 33 + (lane & 31)] = a * gain[k0 + kk]; }
    tr_store(scr, WT, D, drow0, k0, lane);
}
__device__ __forceinline__ void convert_phase(Frame& F, int l) {
    PHASE_IDS();
    unsigned char* const ws_ = wsp(F);
    const float* const ffn1_norm = ldp(F, P_F1N);
    const float* const ffn1_wg = ldp(F, P_F1G);
    const float* const ffn1_wu = ldp(F, P_F1U);
    const float* const ffn1_wd = ldp(F, P_F1D);
    const float* const mix_norm = ldp(F, P_MN);
    const float* const w_in = ldp(F, P_WIN);
    const float* const gate_w2 = ldp(F, P_GW2);
    const float* const w_out = ldp(F, P_WOUT);
    const float* const ffn2_norm = ldp(F, P_F2N);
    const float* const ffn2_wg = ldp(F, P_F2G);
    const float* const ffn2_wu = ldp(F, P_F2U);
    const float* const ffn2_wd = ldp(F, P_F2D);
    bf16* const W = (bf16*)(ws_ + WS_W);
    LAS float* scr = (LAS float*)(F.lds) + wave * 4096;
    const int gw = blockIdx.x * NWAVES + wave, NGW = F.G * NWAVES;
    constexpr int I_G = 16 * 88, I_D = 44 * 32, I_IN = 16 * 80, I_LA = 16 * 8, I_O = 16 * 32, NIT = 4 * I_G + 2 * I_D + I_IN + I_LA + I_O;
    const size_t lw = (size_t)l * D * FF;
    for (int it = gw; it < NIT; it += NGW) {
        int r = it;
        if (r < 4 * I_G) {
            const int sel = r / I_G; r -= sel * I_G; const int kb = r / 88, nb = r % 88, n0 = 32 * nb, which = sel & 1;
            const float* Wsrc = (sel == 0 ? ffn1_wg : sel == 1 ? ffn1_wu : sel == 2 ? ffn2_wg : ffn2_wu) + lw;
            const float* gain = (sel < 2 ? ffn1_norm : ffn2_norm) + l * D;
            tr_item(Wsrc, FF, 64 * kb, n0, gain, W + (sel < 2 ? WE_GU1 : WE_GU2), D, 256 * (n0 >> 7) + 128 * which + (n0 & 127), scr, lane); continue; }
        r -= 4 * I_G;
        if (r < 2 * I_D) { const int sel = r / I_D; r -= sel * I_D; const int kb = r / 32, nb = r % 32;
            tr_item((sel ? ffn2_wd : ffn1_wd) + lw, D, 64 * kb, 32 * nb, nullptr, W + (sel ? WE_D2 : WE_D1), FF, 32 * nb, scr, lane); continue; }
        r -= 2 * I_D;
        if (r < I_IN) { const int kb = r / 80, nb = r % 80, n0 = 32 * nb; int dr = n0;
            if (n0 < 512) dr = 256 * (n0 >> 7) + (n0 & 127); else if (n0 < 1024) dr = 256 * ((n0 - 512) >> 7) + 128 + (n0 & 127);
            tr_item(w_in + (size_t)l * D * IN_W, IN_W, 64 * kb, n0, mix_norm + l * D, W + WE_IN, D, dr, scr, lane); continue; }
        r -= I_IN;
        if (r < I_LA) { const int kb = r / 8, nb = r % 8;
            la_item(w_in + (size_t)l * D * IN_W, gate_w2 + l * 16 * 256, 64 * kb, 32 * nb, mix_norm + l * D, W + WE_IN, 2560 + 32 * nb, scr, lane); continue; }
        r -= I_LA;
        { const int kb = r / 32, nb = r % 32; tr_item(w_out + (size_t)l * D * D, D, 64 * kb, 32 * nb, nullptr, W + WE_OUT, D, 32 * nb, scr, lane); }
    }
}
__device__ __forceinline__ void prep_phase(Frame& F) {
    PHASE_IDS();
    unsigned char* const ws_ = wsp(F);
    const float* const x_prompt = ldp(F, P_XP);
    const float* const x_sample = ldp(F, P_XS);
    float* const SSQ = (float*)(ws_ + WS_SSQ);
    bf16* const XB = (bf16*)(ws_ + WS_XB);
    const int gw = blockIdx.x * NWAVES + wave, NGW = F.G * NWAVES;
    for (int m = gw; m < M; m += NGW) {
        const float* xrow = (m < M_P) ? x_prompt + (size_t)m * D : x_sample + (size_t)(m - M_P) * D;
        const f32x4* xr = (const f32x4*)xrow + lane; f32x4 v[4]; float s = 0.f;
#pragma unroll
        for (int j = 0; j < 4; ++j) { v[j] = xr[64 * j]; s += (v[j].x * v[j].x + v[j].y * v[j].y) + (v[j].z * v[j].z + v[j].w * v[j].w); }
        s = wave_sum(s);
        unsigned long long* o8 = (unsigned long long*)(XB + (size_t)m * D) + lane;
#pragma unroll
        for (int j = 0; j < 4; ++j) o8[64 * j] = (unsigned long long)pk2(v[j].x, v[j].y) | ((unsigned long long)pk2(v[j].z, v[j].w) << 32);
        if (lane < 16) SSQ[(size_t)m * 16 + lane] = (lane == 0) ? s : 0.f;
    }
}
__device__ __forceinline__ void conv_phase(Frame& F, int l) {
    PHASE_IDS();
    unsigned char* const ws_ = wsp(F);
    const float* const cache_conv = ldp(F, P_CC);
    const float* const conv_dw_w = ldp(F, P_DWW);
    const float* const conv_dw_b = ldp(F, P_DWB);
    const float* const conv_ln_g = ldp(F, P_LNG);
    const float* const conv_ln_b = ldp(F, P_LNB);
    bf16* const Z = (bf16*)(ws_ + WS_Z);
    bf16* const CAT = (bf16*)(ws_ + WS_CAT);
    float* const out = outp(F);
    const int c = tid;
    LAS float* sY = (LAS float*)F.lds;
    LAS float* sStat = sY + 16 * 512;
    float w[31];
#pragma unroll
    for (int i = 0; i < 31; ++i) w[i] = conv_dw_w[(size_t)(l * 31 + i) * 512 + c];
    const float bias = conv_dw_b[l * 512 + c], lg = conv_ln_g[l * 512 + c], lb = conv_ln_b[l * 512 + c];
    for (int tile = blockIdx.x; tile < M / 16; tile += F.G) {
        const int m0 = tile * 16; int ms; const float* cache = nullptr;
        if (m0 < M_P) ms = m0 & ~4095; else { const int s = (m0 - M_P) >> 6; ms = M_P + s * 64; cache = cache_conv + (size_t)(l * 32 + s) * 30 * 512; }
        const int t0 = m0 - ms;
        float zv[46];
#pragma unroll
        for (int j = 0; j < 46; ++j) { const int t = t0 - 30 + j; float v = 0.f;
            if (t >= 0) v = bf2f(Z[(size_t)(ms + t) * 512 + c]); else if (cache) v = cache[(30 + t) * 512 + c];
            zv[j] = v; }
        float y[16];
#pragma unroll
        for (int i = 0; i < 16; ++i) { float a = bias;
#pragma unroll
            for (int k = 0; k < 31; ++k) a += w[k] * zv[i + k];
            y[i] = a; sY[i * 512 + c] = a; }
        __syncthreads();
#pragma unroll
        for (int q = 0; q < 2; ++q) { const int i = 2 * wave + q; float v[8]; float s = 0.f;
#pragma unroll
            for (int k = 0; k < 8; ++k) { v[k] = sY[i * 512 + lane + 64 * k]; s += v[k]; }
            const float mean = wave_sum(s) * (1.f / 512.f); float s2 = 0.f;
#pragma unroll
            for (int k = 0; k < 8; ++k) { const float d = v[k] - mean; s2 += d * d; }
            const float rstd = rsqrtf(wave_sum(s2) * (1.f / 512.f) + 1e-6f);
            if (lane == 0) { sStat[2 * i] = mean; sStat[2 * i + 1] = rstd; } }
        __syncthreads();
#pragma unroll
        for (int i = 0; i < 16; ++i) { const float mean = sStat[2 * i], rstd = sStat[2 * i + 1]; float o = (y[i] - mean) * rstd * lg + lb; o = o * __builtin_amdgcn_rcpf(1.f + __expf(-o));
            CAT[(size_t)(m0 + i) * D + c] = (bf16)f2bf(o); }
        __syncthreads();
    }
    for (int rr = blockIdx.x; rr < 36 * 30; rr += F.G) { const int sq = rr / 30, r = rr % 30;
        if (sq < 4) out[OFF_CONV_P + ((size_t)(l * 4 + sq) * 30 + r) * 512 + c] = bf2f(Z[(size_t)(sq * 4096 + 4066 + r) * 512 + c]);
        else { const int s = sq - 4; out[OFF_CONV_S + ((size_t)(l * 32 + s) * 30 + r) * 512 + c] = bf2f(Z[(size_t)(M_P + s * 64 + 34 + r) * 512 + c]); } }
}
typedef float f32x4g __attribute__((ext_vector_type(4)));
constexpr int GP = 72;
__device__ __forceinline__ bf16x8 lds_frag(const LAS unsigned char* base, int row, int col) { return *(const LAS bf16x8*)(base + (row * GP + col) * 2); }
__device__ __forceinline__ v4u pack8(const float (&x)[8]) { v4u o; o.x = pk2(x[0], x[1]); o.y = pk2(x[2], x[3]); o.z = pk2(x[4], x[5]); o.w = pk2(x[6], x[7]); return o; }
__device__ __forceinline__ void chunk_cumsum(const float* LA, size_t m0, int h, int wave, int lane, LAS float* sTot, float (&b)[8]) {
    float run = 0.f;
#pragma unroll
    for (int r = 0; r < 8; ++r) { run += LA[(m0 + wave * 8 + r) * 256 + h * 64 + lane]; b[r] = run; }
    sTot[wave * 64 + lane] = run;
    __syncthreads();
    float off = 0.f;
#pragma unroll
    for (int s2 = 0; s2 < 7; ++s2) off += (s2 < wave) ? sTot[s2 * 64 + lane] : 0.f;
#pragma unroll
    for (int r = 0; r < 8; ++r) b[r] += off;
}
__device__ __forceinline__ void stage_vt(const bf16* V, size_t m0, int h, int tid, LAS unsigned char* sVt) {
    const int v = tid & 127, jg = tid >> 7; float x[16];
#pragma unroll
    for (int j = 0; j < 16; ++j) x[j] = bf2f(V[(m0 + jg * 16 + j) * 512 + h * 128 + v]);
    v4u lo, hi; lo.x = pk2(x[0], x[1]); lo.y = pk2(x[2], x[3]); lo.z = pk2(x[4], x[5]); lo.w = pk2(x[6], x[7]); hi.x = pk2(x[8], x[9]); hi.y = pk2(x[10], x[11]); hi.z = pk2(x[12], x[13]); hi.w = pk2(x[14], x[15]);
    *(LAS v4u*)(sVt + (v * GP + jg * 16) * 2) = lo; *(LAS v4u*)(sVt + (v * GP + jg * 16 + 8) * 2) = hi;
}
__device__ __forceinline__ void gla1_phase(Frame& F, int l) {
    PHASE_IDS();
    unsigned char* const ws_ = wsp(F);
    const float* const state_gla = ldp(F, P_ST0);
    float* const DEC = (float*)(ws_ + WS_DEC);
    const float* const LA = (const float*)(ws_ + WS_LA);
    float* const ST = (float*)(ws_ + WS_ST);
    const bf16* const K = (const bf16*)(ws_ + WS_K);
    const bf16* const V = (const bf16*)(ws_ + WS_V);
    float* const out = outp(F);
    LAS unsigned char* sKt = F.lds;
    LAS unsigned char* sVt = F.lds + 9216;
    LAS float* sTot = (LAS float*)(F.lds + 27648);
    LAS float* sDec = (LAS float*)(F.lds + 29696);
    const int fr = lane & 15, fq = lane >> 4;
    for (int item = blockIdx.x; item < NCH * 4; item += F.G) {
        const int ch = item >> 2, h = item & 3; const size_t m0 = (size_t)ch * 64;
        float b[8];
        chunk_cumsum(LA, m0, h, wave, lane, sTot, b);
        {   float x[8];
#pragma unroll
            for (int r = 0; r < 8; ++r) x[r] = bf2f(K[(m0 + wave * 8 + r) * 256 + h * 64 + lane]) * __expf(-b[r]);
            *(LAS v4u*)(sKt + (lane * GP + wave * 8) * 2) = pack8(x);
            if (wave == 7) { const float dec = __expf(b[7]); sDec[lane] = dec; if (ch < NCH_P) DEC[(ch * 4 + h) * 64 + lane] = dec; }
        }
        stage_vt(V, m0, h, tid, sVt);
        __syncthreads();
        const int kt = wave >> 1, vt0 = 4 * (wave & 1);
        f32x4g acc[4];
#pragma unroll
        for (int t = 0; t < 4; ++t) acc[t] = (f32x4g){0.f, 0.f, 0.f, 0.f};
#pragma unroll
        for (int s2 = 0; s2 < 2; ++s2) { const bf16x8 kf = lds_frag(sKt, 16 * kt + fr, 32 * s2 + 8 * fq);
#pragma unroll
            for (int t = 0; t < 4; ++t) acc[t] = __builtin_amdgcn_mfma_f32_16x16x32_bf16(kf, lds_frag(sVt, 16 * (vt0 + t) + fr, 32 * s2 + 8 * fq), acc[t], 0, 0, 0); }
        const int k0 = 16 * kt + 4 * fq;
        float dec[4];
#pragma unroll
        for (int r = 0; r < 4; ++r) dec[r] = sDec[k0 + r];
#pragma unroll
        for (int t = 0; t < 4; ++t) { const int v = 16 * (vt0 + t) + fr;
            if (ch < NCH_P) { f32x4g o; o[0] = dec[0] * acc[t][0]; o[1] = dec[1] * acc[t][1]; o[2] = dec[2] * acc[t][2]; o[3] = dec[3] * acc[t][3];
                *(f32x4g*)(ST + (((size_t)ch * 4 + h) * 128 + v) * 64 + k0) = o; }
            else {
#pragma unroll
                for (int r = 0; r < 4; ++r) { const size_t idx = (((size_t)(l * 32 + (ch - NCH_P)) * 4 + h) * 64 + k0 + r) * 128 + v; out[OFF_GLA_S + idx] = dec[r] * (state_gla[idx] + acc[t][r]); } } }
        __syncthreads();
    }
}
__device__ __forceinline__ void scan_phase(Frame& F, int l) {
    PHASE_IDS();
    unsigned char* const ws_ = wsp(F);
    float* const ST = (float*)(ws_ + WS_ST);
    const float* const DEC = (const float*)(ws_ + WS_DEC);
    float* const out = outp(F);
    for (int e = blockIdx.x * 512 + tid; e < 4 * 4 * 64 * 128; e += F.G * 512) {
        const int k = e & 63, v = (e >> 6) & 127, h = (e >> 13) & 3, b = e >> 15;
        float* const st = ST + ((size_t)(b * 64) * 4 + h) * 8192 + v * 64 + k;
        const float* const dc = DEC + ((b * 64) * 4 + h) * 64 + k;
        float d[64], dec[64];
#pragma unroll
        for (int c = 0; c < 64; ++c) { d[c] = st[(size_t)c * 32768]; dec[c] = dc[c * 256]; }
        float S = 0.f;
#pragma unroll
        for (int c = 0; c < 64; ++c) { st[(size_t)c * 32768] = S; S = dec[c] * S + d[c]; }
        out[OFF_GLA_P + (((size_t)(l * 4 + b) * 4 + h) * 64 + k) * 128 + v] = S;
    }
}
__device__ __forceinline__ void gla2_phase(Frame& F, int l) {
    PHASE_IDS();
    unsigned char* const ws_ = wsp(F);
    const float* const state_gla = ldp(F, P_ST0);
    const float* const gla_norm_g = ldp(F, P_GNG);
    const float* const LA = (const float*)(ws_ + WS_LA);
    const float* const ST = (const float*)(ws_ + WS_ST);
    const bf16* const Q = (const bf16*)(ws_ + WS_Q);
    const bf16* const K = (const bf16*)(ws_ + WS_K);
    const bf16* const V = (const bf16*)(ws_ + WS_V);
    const bf16* const SG = (const bf16*)(ws_ + WS_SG);
    bf16* const CAT = (bf16*)(ws_ + WS_CAT);
    LAS unsigned char* sQ = F.lds;
    LAS unsigned char* sK = F.lds + 9216;
    LAS unsigned char* sVt = F.lds + 18432;
    LAS unsigned char* sSt = F.lds + 36864;
    LAS unsigned char* sA = F.lds + 55296;
    LAS float* sTot = (LAS float*)(F.lds + 64512);
    LAS float* sRS = (LAS float*)(F.lds + 66560);
    const int fr = lane & 15, fq = lane >> 4;
    for (int item = blockIdx.x; item < NCH * 4; item += F.G) {
        const int ch = item >> 2, h = item & 3; const size_t m0 = (size_t)ch * 64;
        float b[8];
        chunk_cumsum(LA, m0, h, wave, lane, sTot, b);
#pragma unroll
        for (int r = 0; r < 8; ++r) { const size_t a = (m0 + wave * 8 + r) * 256 + h * 64 + lane; const int o = ((wave * 8 + r) * GP + lane) * 2;
            *(LAS bf16*)(sQ + o) = (bf16)f2bf(bf2f(Q[a]) * __expf(b[r])); *(LAS bf16*)(sK + o) = (bf16)f2bf(bf2f(K[a]) * __expf(-b[r])); }
        stage_vt(V, m0, h, tid, sVt);
        if (ch < NCH_P) {
            const int v = tid >> 2, kq = tid & 3; const f32x4g* src = (const f32x4g*)(ST + (((size_t)ch * 4 + h) * 128 + v) * 64 + 16 * kq);
            const f32x4g a0 = src[0], a1 = src[1], a2 = src[2], a3 = src[3];
            v4u lo, hi; lo.x = pk2(a0[0], a0[1]); lo.y = pk2(a0[2], a0[3]); lo.z = pk2(a1[0], a1[1]); lo.w = pk2(a1[2], a1[3]); hi.x = pk2(a2[0], a2[1]); hi.y = pk2(a2[2], a2[3]); hi.z = pk2(a3[0], a3[1]); hi.w = pk2(a3[2], a3[3]);
            *(LAS v4u*)(sSt + (v * GP + 16 * kq) * 2) = lo; *(LAS v4u*)(sSt + (v * GP + 16 * kq + 8) * 2) = hi;
        } else {
            const int v = tid & 127, kg = tid >> 7; const float* src = state_gla + (((size_t)(l * 32 + (ch - NCH_P)) * 4 + h) * 64 + kg * 16) * 128 + v; float x[16];
#pragma unroll
            for (int j = 0; j < 16; ++j) x[j] = src[j * 128];
            v4u lo, hi; lo.x = pk2(x[0], x[1]); lo.y = pk2(x[2], x[3]); lo.z = pk2(x[4], x[5]); lo.w = pk2(x[6], x[7]); hi.x = pk2(x[8], x[9]); hi.y = pk2(x[10], x[11]); hi.z = pk2(x[12], x[13]); hi.w = pk2(x[14], x[15]);
            *(LAS v4u*)(sSt + (v * GP + kg * 16) * 2) = lo; *(LAS v4u*)(sSt + (v * GP + kg * 16 + 8) * 2) = hi;
        }
        __syncthreads();
        const int it = wave >> 1;
        {
            const bf16x8 q0 = lds_frag(sQ, 16 * it + fr, 8 * fq), q1 = lds_frag(sQ, 16 * it + fr, 32 + 8 * fq);
#pragma unroll
            for (int t = 0; t < 2; ++t) { const int jt = 2 * (wave & 1) + t; f32x4g a = (f32x4g){0.f, 0.f, 0.f, 0.f};
                if (jt <= it) { a = __builtin_amdgcn_mfma_f32_16x16x32_bf16(lds_frag(sK, 16 * jt + fr, 8 * fq), q0, a, 0, 0, 0); a = __builtin_amdgcn_mfma_f32_16x16x32_bf16(lds_frag(sK, 16 * jt + fr, 32 + 8 * fq), q1, a, 0, 0, 0); }
                const int i = 16 * it + fr, j0 = 16 * jt + 4 * fq;
                typedef unsigned u32x2g __attribute__((ext_vector_type(2)));
                u32x2g w; w.x = pk2(j0 + 0 <= i ? a[0] : 0.f, j0 + 1 <= i ? a[1] : 0.f); w.y = pk2(j0 + 2 <= i ? a[2] : 0.f, j0 + 3 <= i ? a[3] : 0.f);
                *(LAS u32x2g*)(sA + (i * GP + j0) * 2) = w; }
        }
        __syncthreads();
        const int vt0 = 4 * (wave & 1);
        f32x4g acc[4];
#pragma unroll
        for (int t = 0; t < 4; ++t) acc[t] = (f32x4g){0.f, 0.f, 0.f, 0.f};
#pragma unroll
        for (int s2 = 0; s2 < 2; ++s2) { const bf16x8 qf = lds_frag(sQ, 16 * it + fr, 32 * s2 + 8 * fq), af = lds_frag(sA, 16 * it + fr, 32 * s2 + 8 * fq);
#pragma unroll
            for (int t = 0; t < 4; ++t) { acc[t] = __builtin_amdgcn_mfma_f32_16x16x32_bf16(lds_frag(sSt, 16 * (vt0 + t) + fr, 32 * s2 + 8 * fq), qf, acc[t], 0, 0, 0);
                acc[t] = __builtin_amdgcn_mfma_f32_16x16x32_bf16(lds_frag(sVt, 16 * (vt0 + t) + fr, 32 * s2 + 8 * fq), af, acc[t], 0, 0, 0); } }
        float p = 0.f;
#pragma unroll
        for (int t = 0; t < 4; ++t) p += (acc[t][0] * acc[t][0] + acc[t][1] * acc[t][1]) + (acc[t][2] * acc[t][2] + acc[t][3] * acc[t][3]);
        p += __shfl_xor(p, 16); p += __shfl_xor(p, 32);
        if (fq == 0) sRS[(wave & 1) * 64 + 16 * it + fr] = p;
        __syncthreads();
        const float rs = rsqrtf((sRS[16 * it + fr] + sRS[64 + 16 * it + fr]) * (1.f / 128.f) + 1e-6f);
        const size_t m = m0 + 16 * it + fr;
#pragma unroll
        for (int t = 0; t < 4; ++t) { const int c = h * 128 + 16 * (vt0 + t) + 4 * fq;
            const f32x4g g4 = *(const f32x4g*)(gla_norm_g + l * 512 + c);
            typedef unsigned u32x2g __attribute__((ext_vector_type(2)));
            const u32x2g sg = *(const u32x2g*)(SG + m * 512 + c);
            const float s0 = __builtin_bit_cast(float, sg.x << 16), s1 = __builtin_bit_cast(float, sg.x & 0xffff0000u), s2 = __builtin_bit_cast(float, sg.y << 16), s3 = __builtin_bit_cast(float, sg.y & 0xffff0000u);
            u32x2g w; w.x = pk2(acc[t][0] * rs * g4[0] * s0, acc[t][1] * rs * g4[1] * s1); w.y = pk2(acc[t][2] * rs * g4[2] * s2, acc[t][3] * rs * g4[3] * s3);
            *(u32x2g*)(CAT + m * D + 512 + c) = w; }
        __syncthreads();
    }
}
__device__ __forceinline__ void final_phase(Frame& F) {
    PHASE_IDS();
    unsigned char* const ws_ = wsp(F);
    const float* const final_norm = ldp(F, P_FN);
    float* const SSQ = (float*)(ws_ + WS_SSQ);
    float* const out = outp(F);
    const int gw = blockIdx.x * NWAVES + wave, NGW = F.G * NWAVES;
    for (int m = gw; m < M; m += NGW) { const float rs = pg8::row_rs(SSQ, m); f32x4* xr = (f32x4*)(out + (size_t)m * D) + lane; const f32x4* gn = (const f32x4*)final_norm + lane;
#pragma unroll
        for (int j = 0; j < 4; ++j) xr[64 * j] = xr[64 * j] * gn[64 * j] * rs; }
}

struct Args { const float* in[23]; float* out; unsigned char* ws; };
#ifndef REP_CONV
#define REP_CONV 1
#endif
#ifndef REP_GLA1
#define REP_GLA1 1
#endif
#ifndef REP_GLA2
#define REP_GLA2 1
#endif
#ifndef REP_GU
#define REP_GU 1
#endif
#ifndef REP_IN
#define REP_IN 1
#endif
#ifndef REP_CVT
#define REP_CVT 1
#endif
#ifndef MK_STEP_LO
#define MK_STEP_LO 0
#define MK_STEP_HI 20
#endif
__device__ __forceinline__ void grid_barrier(const Frame& F) {
#if MK_CG_ALL
    cg::this_grid().sync();
#else
    XcdBarrier b; b.bar = (unsigned*)wsp(F) + CW_BAR; b.x = xb_xcc_id(); b.st = (volatile LAS unsigned*)(F.lds + MISC_OFF) + 8;
    xcd_barrier(b, F.wave);
#endif
}
__global__ void __launch_bounds__(NWAVES * 64, 2) mk_fwd(Args args) {
    extern __shared__ __attribute__((aligned(16))) unsigned char lds[];
    Frame F;
    F.lds = (LAS unsigned char*)lds;
    F.G = gridDim.x; const int tid0 = threadIdx.x; F.wave = __builtin_amdgcn_readfirstlane(tid0 >> 6);
    for (int u = tid0; u < (LDS_BYTES - LDSCTL_OFF) / 4; u += NWAVES * 64) ((LAS unsigned*)(F.lds + LDSCTL_OFF))[u] = 0u;
    __syncthreads();
    if (tid0 < P_COUNT) { const unsigned long long p = tid0 < 23 ? (unsigned long long)args.in[tid0 < 23 ? tid0 : 0] : (tid0 == P_OUT ? (unsigned long long)args.out : (unsigned long long)args.ws);
        LAS unsigned* t = (LAS unsigned*)(F.lds + PT_OFF) + 2 * tid0; t[0] = (unsigned)p; t[1] = (unsigned)(p >> 32); }
    __syncthreads();
    (void)xcd_barrier_post((unsigned*)wsp(F) + CW_BAR, (volatile LAS unsigned*)(F.lds + MISC_OFF) + 8, F.wave);
    for (int rep = 0; rep < REP_CVT; ++rep) { prep_phase(F); convert_phase(F, 0); }
    cg::this_grid().sync();
    for (int step = MK_STEP_LO; step < MK_STEP_HI; ++step) {
        const int l = step / 10, p = step - 10 * l;
        if (p == 0 || p == 7) {
            unsigned char* const ws_ = wsp(F);
            pg8::Gemm g{(const bf16*)(ws_ + WS_XB), (const bf16*)(ws_ + WS_W) + (p == 0 ? WE_GU1 : WE_GU2), M, 2 * FF, D}; pg8::StaticOrder S; S.init(M, 2 * FF, F.G, (int)blockIdx.x);
            pg8::EpiGU E{(bf16*)(ws_ + WS_HID), (const float*)(ws_ + WS_SSQ)};
            for (int rep = 0; rep < REP_GU; ++rep) pg8::gemm_phase<pg8::EpiGU, pg8::StaticOrder, true, true>(F.lds, g, S, E, F.wave);
        } else if (p == 1 || p == 6 || p == 8) {
            unsigned char* const ws_ = wsp(F); float* const out = outp(F);
            const bool first = (step == 1);
            pg8::Gemm g{(const bf16*)(ws_ + (p == 6 ? WS_CAT : WS_HID)), (const bf16*)(ws_ + WS_W) + (p == 1 ? WE_D1 : p == 6 ? WE_OUT : WE_D2), M, D, p == 6 ? D : FF}; pg8::StaticOrder S; S.init(M, D, F.G, (int)blockIdx.x);
            pg8::EpiRes E{first ? ldp(F, P_XP) : out, first ? ldp(F, P_XS) - (size_t)M_P * D : out, out, (bf16*)(ws_ + WS_XB), (float*)(ws_ + WS_SSQ), p == 6 ? 1.0f : 0.5f};
            pg8::gemm_phase<pg8::EpiRes, pg8::StaticOrder, true, true>(F.lds, g, S, E, F.wave);
        } else if (p == 2) {
            unsigned char* const ws_ = wsp(F);
            pg8::Gemm g{(const bf16*)(ws_ + WS_XB), (const bf16*)(ws_ + WS_W) + WE_IN, M, NIN, D}; pg8::StaticOrder S; S.init(M, NIN, F.G, (int)blockIdx.x);
            pg8::EpiIn E{(bf16*)(ws_ + WS_Z), (bf16*)(ws_ + WS_Q), (bf16*)(ws_ + WS_K), (bf16*)(ws_ + WS_V), (bf16*)(ws_ + WS_SG), (float*)(ws_ + WS_LA), (const float*)(ws_ + WS_SSQ), ldp(F, P_GB) + l * 256};
            for (int rep = 0; rep < REP_IN; ++rep) pg8::gemm_phase<pg8::EpiIn, pg8::StaticOrder, true, true>(F.lds, g, S, E, F.wave);
        } else if (p == 3) { for (int rep = 0; rep < REP_CONV; ++rep) conv_phase(F, l); for (int rep = 0; rep < REP_GLA1; ++rep) gla1_phase(F, l); }
        else if (p == 4) scan_phase(F, l);
        else if (p == 5) { for (int rep = 0; rep < REP_GLA2; ++rep) gla2_phase(F, l); }
        else { if (l + 1 < NL) { for (int rep = 0; rep < REP_CVT; ++rep) convert_phase(F, l + 1); } else continue; }
        grid_barrier(F);
    }
    final_phase(F);
}

extern "C" void kernel_launch(void* const* d_in, const int* in_sizes, int n_in, void* d_out, int out_size, void* d_ws, size_t ws_size, hipStream_t stream) {
    static int grid = 0;
    if (grid == 0) {
        if (n_in != 23 || in_sizes[0] != M_P * D || in_sizes[1] != M_S * D || (size_t)out_size != OUT_END || ws_size < WS_END) {
            fprintf(stderr, "kernel_launch: unexpected shapes (n_in %d, in0 %d, in1 %d, out %d, ws %zu); nothing launched\n", n_in, n_in > 0 ? in_sizes[0] : -1, n_in > 1 ? in_sizes[1] : -1, out_size, ws_size); grid = -1; return; }
        int dev = 0, cus = 0, per_cu = 0;
        if (hipGetDevice(&dev) != hipSuccess || hipDeviceGetAttribute(&cus, hipDeviceAttributeMultiprocessorCount, dev) != hipSuccess) { grid = -1; return; }
        if (hipFuncSetAttribute((const void*)mk_fwd, hipFuncAttributeMaxDynamicSharedMemorySize, LDS_BYTES) != hipSuccess) { fprintf(stderr, "kernel_launch: hipFuncSetAttribute failed\n"); grid = -1; return; }
        if (hipOccupancyMaxActiveBlocksPerMultiprocessor(&per_cu, (const void*)mk_fwd, NWAVES * 64, LDS_BYTES) != hipSuccess || per_cu < 1) { fprintf(stderr, "kernel_launch: occupancy query failed (%d)\n", per_cu); (void)hipGetLastError(); grid = -1; return; }
        grid = cus * 1;
    }
    if (grid < 0) return;
    if (hipMemsetAsync((char*)d_ws + WS_CTL, 0, CTL_ZERO_BYTES, stream) != hipSuccess) { fprintf(stderr, "kernel_launch: hipMemsetAsync failed\n"); return; }
    Args a{};
    for (int i = 0; i < 23; ++i) a.in[i] = (const float*)d_in[i];
    a.out = (float*)d_out; a.ws = (unsigned char*)d_ws;
    void* params[] = {&a};
    const hipError_t e = hipLaunchCooperativeKernel((const void*)mk_fwd, dim3(grid), dim3(NWAVES * 64), params, LDS_BYTES, stream);
    if (e != hipSuccess) fprintf(stderr, "kernel_launch: cooperative launch failed: %s (grid %d)\n", hipGetErrorString(e), grid);
}
```
